# Optimizing an MI355X kernel written in HIP

```python
import math
import numpy as np
import jax
import jax.numpy as jnp
from jax import lax

D_MODEL = 1024
BATCH = 16
SEQ = 256
DEPTH = 4
DEC_BATCH = 2
DEC_SEQ = 1024
PAST_LEN = 512

GRID_W = 64
HEAD_DIM = 64
NA_HEADS = 4
NA_WIN_ROWS = 8
NA_WIN_COLS = 16
DIFF_HEADS = 4
DIFF_QK_DIM = 32
DIFF_V_DIM = 64
MLA_HEADS = 4
MLA_NOPE = 64
MLA_ROPE = 32
MLA_V = 64
MLA_KV_RANK = 128
SGU_GROUPS = 4
SGU_GROUP_DIM = 64
SGU_CHUNK = 128
D_FF = 4 * D_MODEL
ROPE_BASE = 10000.0
QBLOCK = 128
EPS = 1e-6
NEG_INF = -1e30

WIDTH_A = NA_HEADS * HEAD_DIM
WIDTH_B = DIFF_HEADS * DIFF_V_DIM
WIDTH_C = MLA_HEADS * MLA_V
WIDTH_D = SGU_GROUPS * SGU_GROUP_DIM
MIX_WIDTH = WIDTH_A + WIDTH_B + WIDTH_C + WIDTH_D
DIFF_QK_W = DIFF_HEADS * 2 * DIFF_QK_DIM
MLA_Q_W = MLA_HEADS * (MLA_NOPE + MLA_ROPE)
IN_SPLITS = (WIDTH_A, WIDTH_A, WIDTH_A, DIFF_QK_W, DIFF_QK_W, WIDTH_B,
             MLA_Q_W, MLA_KV_RANK, MLA_ROPE, WIDTH_D, WIDTH_D)
IN_COLS = 3 * WIDTH_A + 2 * DIFF_QK_W + WIDTH_B + MLA_Q_W + MLA_KV_RANK + MLA_ROPE + 2 * WIDTH_D

kernel_name = 'hybrid_na_diff_mla_sgu_dit_step'


def rmsnorm(x, g):
    xf = x.astype(jnp.float32)
    y = xf * lax.rsqrt(jnp.mean(xf * xf, axis=-1, keepdims=True) + EPS)
    return (y * g.astype(jnp.float32)).astype(x.dtype)


def _heads(x, n):
    b, s, _ = x.shape
    return x.reshape(b, s, n, -1).transpose(0, 2, 1, 3)


def _merge(x):
    b, h, s, d = x.shape
    return x.transpose(0, 2, 1, 3).reshape(b, s, h * d)


def _rope1d(x, pos):
    half = x.shape[-1] // 2
    freqs = ROPE_BASE ** (-jnp.arange(half, dtype=jnp.float32) / half)
    ang = pos[:, None] * freqs[None, :]
    cos, sin = jnp.cos(ang).astype(x.dtype), jnp.sin(ang).astype(x.dtype)
    x1, x2 = x[..., :half], x[..., half:]
    return jnp.concatenate([x1 * cos - x2 * sin, x2 * cos + x1 * sin], axis=-1)


def rope2d(x, rows, cols):
    r = x.shape[-1] // 2
    return jnp.concatenate([_rope1d(x[..., :r], rows), _rope1d(x[..., r:], cols)], axis=-1)


def _grid_positions(s):
    t = jnp.arange(s)
    return (t // GRID_W).astype(jnp.float32), (t % GRID_W).astype(jnp.float32)


def _map_query_blocks(fn, *qs):
    b, h, s = qs[0].shape[:3]
    nb = s // QBLOCK
    blocks = tuple(q.reshape(b, h, nb, QBLOCK, q.shape[-1]).transpose(2, 0, 1, 3, 4) for q in qs)
    out = lax.map(lambda a: fn(*a), blocks)
    return out.transpose(1, 2, 0, 3, 4).reshape(b, h, s, out.shape[-1])


def dense_attn(q, k, v, scale):
    def blk(qb):
        s = jnp.einsum('bhqd,bhkd->bhqk', qb, k).astype(jnp.float32) * scale
        p = jax.nn.softmax(s, axis=-1).astype(v.dtype)
        return jnp.einsum('bhqk,bhkd->bhqd', p, v)
    return _map_query_blocks(blk, q)


def diff_attn(q1, q2, k1, k2, v, lam, scale):
    def blk(q1b, q2b):
        s1 = jnp.einsum('bhqd,bhkd->bhqk', q1b, k1).astype(jnp.float32) * scale
        s2 = jnp.einsum('bhqd,bhkd->bhqk', q2b, k2).astype(jnp.float32) * scale
        p = jax.nn.softmax(s1, axis=-1) - lam * jax.nn.softmax(s2, axis=-1)
        return jnp.einsum('bhqk,bhkd->bhqd', p.astype(v.dtype), v)
    return _map_query_blocks(blk, q1, q2)


def mla_attn(q_nope, q_pe, k_nope, k_pe, v, scale):
    def blk(qn, qp):
        s = (jnp.einsum('bhqd,bhkd->bhqk', qn, k_nope)
             + jnp.einsum('bhqr,bkr->bhqk', qp, k_pe)).astype(jnp.float32) * scale
        p = jax.nn.softmax(s, axis=-1).astype(v.dtype)
        return jnp.einsum('bhqk,bhkd->bhqd', p, v)
    return _map_query_blocks(blk, q_nope, q_pe)


def neighbourhood_attn(q, k, v, k_ctx, v_ctx, rpb):
    b, h, s, d = q.shape
    rows = s // GRID_W
    kh = min(NA_WIN_ROWS, rows)
    kw = NA_WIN_COLS
    scale = d ** -0.5
    lc = k_ctx.shape[2]
    cols = jnp.arange(GRID_W)
    c0 = jnp.clip(cols - kw // 2, 0, GRID_W - kw)
    in_win = (cols[None, :] >= c0[:, None]) & (cols[None, :] < c0[:, None] + kw)
    dcol = jnp.clip(cols[None, :] - cols[:, None], -(kw - 1), kw - 1) + (kw - 1)
    qg = q.reshape(b, h, rows, GRID_W, d).transpose(2, 0, 1, 3, 4)
    kg = k.reshape(b, h, rows, GRID_W, d)
    vg = v.reshape(b, h, rows, GRID_W, d)

    def row_block(args):
        r, qr = args
        r0 = jnp.clip(r - kh // 2, 0, rows - kh)
        kr = lax.dynamic_slice_in_dim(kg, r0, kh, axis=2)
        vr = lax.dynamic_slice_in_dim(vg, r0, kh, axis=2)
        drow = r0 + jnp.arange(kh) - r + (NA_WIN_ROWS - 1)
        bias = rpb[:, drow[None, :, None], dcol[:, None, :]]
        s_loc = (jnp.einsum('bhqd,bhikd->bhqik', qr, kr).astype(jnp.float32) * scale
                 + bias.astype(jnp.float32))
        s_loc = jnp.where(in_win[:, None, :], s_loc, NEG_INF)
        s_ctx = jnp.einsum('bhqd,bhkd->bhqk', qr, k_ctx).astype(jnp.float32) * scale
        s_all = jnp.concatenate([s_ctx, s_loc.reshape(b, h, GRID_W, kh * GRID_W)], axis=-1)
        p = jax.nn.softmax(s_all, axis=-1).astype(v.dtype)
        p_loc = p[..., lc:].reshape(b, h, GRID_W, kh, GRID_W)
        return (jnp.einsum('bhqk,bhkd->bhqd', p[..., :lc], v_ctx)
                + jnp.einsum('bhqik,bhikd->bhqd', p_loc, vr))

    out = lax.map(row_block, (jnp.arange(rows), qg))
    return out.transpose(1, 2, 0, 3, 4).reshape(b, h, s, d)


def spatial_gating(u, v, lp):
    u = jax.nn.gelu(u)
    v = jax.nn.gelu(v)
    bsz, length, _ = u.shape
    n = length // SGU_CHUNK
    vg = rmsnorm(v.reshape(bsz, n, SGU_CHUNK, SGU_GROUPS, SGU_GROUP_DIM), lp['sgu_g'])
    mixed = jnp.einsum('gpq,bnqgc->bnpgc', lp['sgu_w'], vg) + lp['sgu_b'].T[:, :, None]
    return u * mixed.reshape(bsz, length, WIDTH_D)


def _in_proj(h, w):
    points = np.cumsum(IN_SPLITS)[:-1].tolist()
    return jnp.split(h @ w, points, axis=-1)


def _diff_lambda(lp, lam_init):
    f = jnp.float32
    return (jnp.exp(jnp.sum((lp['diff_lq1'] * lp['diff_lk1']).astype(f)))
            - jnp.exp(jnp.sum((lp['diff_lq2'] * lp['diff_lk2']).astype(f))) + lam_init)


def _diff_mixer(q, k, v, lp, lam_init):
    lam = _diff_lambda(lp, lam_init)
    o = diff_attn(q[..., :DIFF_QK_DIM], q[..., DIFF_QK_DIM:], k[..., :DIFF_QK_DIM], k[..., DIFF_QK_DIM:],
                  v, lam, DIFF_QK_DIM ** -0.5)
    return rmsnorm(o, lp['diff_g_subln']) * (1.0 - lam_init)


def _rope_pair(x, rows, cols):
    return jnp.concatenate([rope2d(x[..., :DIFF_QK_DIM], rows, cols),
                            rope2d(x[..., DIFF_QK_DIM:], rows, cols)], axis=-1)


def _mla_mixer(q_nope, q_pe, ckv_all, kpe_all, lp):
    k_nope = _heads(ckv_all @ lp['mla_w_uk'], MLA_HEADS)
    v = _heads(ckv_all @ lp['mla_w_uv'], MLA_HEADS)
    return mla_attn(q_nope, q_pe, k_nope, kpe_all, v, (MLA_NOPE + MLA_ROPE) ** -0.5)


def _mix_context(h, lp, lam_init):
    qa, ka, va, qb, kb, vb, qc, ckv, kpe, u, vs = _in_proj(h, lp['w_in'])
    qa, ka, va = _heads(qa, NA_HEADS), _heads(ka, NA_HEADS), _heads(va, NA_HEADS)
    o_a = dense_attn(qa, ka, va, HEAD_DIM ** -0.5)
    qb, kb, vb = _heads(qb, DIFF_HEADS), _heads(kb, DIFF_HEADS), _heads(vb, DIFF_HEADS)
    o_b = _diff_mixer(qb, kb, vb, lp, lam_init)
    ckv = rmsnorm(ckv, lp['mla_g_ckv'])
    qc = _heads(qc, MLA_HEADS)
    o_c = _mla_mixer(qc[..., :MLA_NOPE], qc[..., MLA_NOPE:], ckv, kpe, lp)
    o_d = spatial_gating(u, vs, lp)
    out = jnp.concatenate([_merge(o_a), _merge(o_b), _merge(o_c), o_d], axis=-1)
    return out, (ka, va, kb, vb, ckv, kpe)


def _mix_latent(h, lp, lam_init, na_k, na_v, diff_k, diff_v, mla_ckv, mla_kpe):
    qa, ka, va, qb, kb, vb, qc, ckv, kpe, u, vs = _in_proj(h, lp['w_in'])
    rows, cols = _grid_positions(h.shape[1])
    qa, ka, va = _heads(qa, NA_HEADS), _heads(ka, NA_HEADS), _heads(va, NA_HEADS)
    o_a = neighbourhood_attn(qa, ka, va, na_k, na_v, lp['na_rpb'])
    qb = _rope_pair(_heads(qb, DIFF_HEADS), rows, cols)
    kb = _rope_pair(_heads(kb, DIFF_HEADS), rows, cols)
    vb = _heads(vb, DIFF_HEADS)
    o_b = _diff_mixer(qb, jnp.concatenate([diff_k, kb], axis=2), jnp.concatenate([diff_v, vb], axis=2),
                      lp, lam_init)
    ckv = rmsnorm(ckv, lp['mla_g_ckv'])
    kpe = rope2d(kpe, rows, cols)
    qc = _heads(qc, MLA_HEADS)
    o_c = _mla_mixer(qc[..., :MLA_NOPE], rope2d(qc[..., MLA_NOPE:], rows, cols),
                     jnp.concatenate([mla_ckv, ckv], axis=1), jnp.concatenate([mla_kpe, kpe], axis=1), lp)
    o_d = spatial_gating(u, vs, lp)
    return jnp.concatenate([_merge(o_a), _merge(o_b), _merge(o_c), o_d], axis=-1)


def _block(x, m, lp, mix):
    e = jax.nn.silu(m) @ lp['w_ada'] + lp['b_ada']
    sh1, sc1, g1, sh2, sc2, g2 = jnp.split(e, 6, axis=-1)
    h = rmsnorm(x, lp['g_mix']) * (1 + sc1[:, None]) + sh1[:, None]
    o, extra = mix(h)
    x = x + g1[:, None] * (o @ lp['w_out'])
    hf = rmsnorm(x, lp['g_ffn']) * (1 + sc2[:, None]) + sh2[:, None]
    x = x + g2[:, None] * (jnp.square(jax.nn.relu(hf @ lp['w_ff1'])) @ lp['w_ff2'])
    return x, extra


def setup_inputs(seed: int = 0) -> dict:
    key = jax.random.key(seed)
    ks = jax.random.split(key, 32)
    f32 = jnp.float32

    def nrm(k, shape, s):
        return jax.random.normal(k, shape, f32) * s

    def gain(k, shape):
        return 1.0 + 0.01 * jax.random.normal(k, shape, f32)

    L, D = DEPTH, D_MODEL
    return {
        'x_prompt': nrm(ks[0], (BATCH, SEQ, D), 1.0),
        'x_sample': nrm(ks[1], (DEC_BATCH, DEC_SEQ, D), 1.0),
        'cache_na_k': nrm(ks[2], (DEC_BATCH, L, NA_HEADS, PAST_LEN, HEAD_DIM), 1.0),
        'cache_na_v': nrm(ks[3], (DEC_BATCH, L, NA_HEADS, PAST_LEN, HEAD_DIM), 1.0),
        'cache_diff_k': nrm(ks[4], (DEC_BATCH, L, DIFF_HEADS, PAST_LEN, 2 * DIFF_QK_DIM), 1.0),
        'cache_diff_v': nrm(ks[5], (DEC_BATCH, L, DIFF_HEADS, PAST_LEN, DIFF_V_DIM), 1.0),
        'cache_mla_ckv': nrm(ks[6], (DEC_BATCH, L, PAST_LEN, MLA_KV_RANK), 1.0),
        'cache_mla_kpe': nrm(ks[7], (DEC_BATCH, L, PAST_LEN, MLA_ROPE), 1.0),
        'c': nrm(ks[8], (DEC_BATCH, D), 1.0),
        'c_ctx': nrm(ks[9], (D,), 1.0),
        'w_ada': nrm(ks[10], (L, D, 6 * D), D ** -0.5),
        'b_ada': nrm(ks[11], (L, 6 * D), 0.01),
        'g_mix': gain(ks[12], (L, D)),
        'g_ffn': gain(ks[13], (L, D)),
        'w_in': nrm(ks[14], (L, D, IN_COLS), D ** -0.5),
        'w_out': nrm(ks[15], (L, MIX_WIDTH, D), MIX_WIDTH ** -0.5),
        'na_rpb': nrm(ks[16], (L, NA_HEADS, 2 * NA_WIN_ROWS - 1, 2 * NA_WIN_COLS - 1), 0.1),
        'diff_lq1': nrm(ks[17], (L, DIFF_QK_DIM), 0.1),
        'diff_lk1': nrm(ks[18], (L, DIFF_QK_DIM), 0.1),
        'diff_lq2': nrm(ks[19], (L, DIFF_QK_DIM), 0.1),
        'diff_lk2': nrm(ks[20], (L, DIFF_QK_DIM), 0.1),
        'diff_g_subln': gain(ks[21], (L, DIFF_V_DIM)),
        'mla_g_ckv': gain(ks[22], (L, MLA_KV_RANK)),
        'mla_w_uk': nrm(ks[23], (L, MLA_KV_RANK, MLA_HEADS * MLA_NOPE), MLA_KV_RANK ** -0.5),
        'mla_w_uv': nrm(ks[24], (L, MLA_KV_RANK, MLA_HEADS * MLA_V), MLA_KV_RANK ** -0.5),
        'sgu_g': gain(ks[25], (L, SGU_GROUPS, SGU_GROUP_DIM)),
        'sgu_w': nrm(ks[26], (L, SGU_GROUPS, SGU_CHUNK, SGU_CHUNK), SGU_CHUNK ** -0.5),
        'sgu_b': gain(ks[27], (L, SGU_GROUPS, SGU_CHUNK)),
        'w_ff1': nrm(ks[28], (L, D, D_FF), D ** -0.5),
        'w_ff2': nrm(ks[29], (L, D_FF, D), D_FF ** -0.5),
        'g_final': gain(ks[30], (D,)),
    }


def reference(x_prompt, x_sample, cache_na_k, cache_na_v, cache_diff_k, cache_diff_v,
              cache_mla_ckv, cache_mla_kpe, c, c_ctx,
              w_ada, b_ada, g_mix, g_ffn, w_in, w_out, na_rpb,
              diff_lq1, diff_lk1, diff_lq2, diff_lk2, diff_g_subln,
              mla_g_ckv, mla_w_uk, mla_w_uv, sgu_g, sgu_w, sgu_b, w_ff1, w_ff2, g_final):
    stacked = {
        'w_ada': w_ada, 'b_ada': b_ada, 'g_mix': g_mix, 'g_ffn': g_ffn, 'w_in': w_in, 'w_out': w_out,
        'na_rpb': na_rpb, 'diff_lq1': diff_lq1, 'diff_lk1': diff_lk1, 'diff_lq2': diff_lq2,
        'diff_lk2': diff_lk2, 'diff_g_subln': diff_g_subln, 'mla_g_ckv': mla_g_ckv,
        'mla_w_uk': mla_w_uk, 'mla_w_uv': mla_w_uv, 'sgu_g': sgu_g, 'sgu_w': sgu_w, 'sgu_b': sgu_b,
        'w_ff1': w_ff1, 'w_ff2': w_ff2,
    }
    m_ctx = c_ctx[None, :]
    y_p = x_prompt
    y_s = x_sample
    st = ([], [], [], [], [], [])
    for l in range(DEPTH):
        lp = {name: arr[l] for name, arr in stacked.items()}
        lam_init = 0.8 - 0.6 * math.exp(-0.3 * l)
        y_p, ctx = _block(y_p, m_ctx, lp, lambda h: _mix_context(h, lp, lam_init))
        for lst, t in zip(st, ctx):
            lst.append(t)
        y_s, _ = _block(y_s, c, lp, lambda h: (_mix_latent(
            h, lp, lam_init, cache_na_k[:, l], cache_na_v[:, l], cache_diff_k[:, l], cache_diff_v[:, l],
            cache_mla_ckv[:, l], cache_mla_kpe[:, l]), None))
    y_prompt = rmsnorm(y_p, g_final)
    y_sample = rmsnorm(y_s, g_final)
    new_na_k = jnp.stack(st[0], axis=1)
    new_na_v = jnp.stack(st[1], axis=1)
    new_diff_k = jnp.stack(st[2], axis=1)
    new_diff_v = jnp.stack(st[3], axis=1)
    new_mla_ckv = jnp.stack(st[4], axis=1)
    new_mla_kpe = jnp.stack(st[5], axis=1)
    return (y_prompt, y_sample, new_na_k, new_na_v, new_diff_k, new_diff_v, new_mla_ckv, new_mla_kpe)
```

```cpp
#include <hip/hip_runtime.h>
#include <hip/hip_cooperative_groups.h>
#include <cstdio>
namespace cg = cooperative_groups;

typedef unsigned short u16;
typedef float f4v __attribute__((ext_vector_type(4)));
#define NT_LD4(p) ([&]{ f4v _t = __builtin_nontemporal_load(reinterpret_cast<const f4v*>(p)); return float4{_t.x, _t.y, _t.z, _t.w}; }())
using bf16x8 = __attribute__((ext_vector_type(8))) short;
using bf16x4 = __attribute__((ext_vector_type(4))) short;
using f32x4 = __attribute__((ext_vector_type(4))) float;
#define DEV __device__ __forceinline__

constexpr int DM = 1024, NP = 4096, NS = 2048, NT = 6144, NL = 4;
constexpr int INC = 2592, INP = 2688, FF = 4096;
constexpr int C_QA = 0, C_KA = 256, C_VA = 512, C_QB = 768, C_KB = 1024, C_VB = 1280, C_QC = 1536, C_CKV = 1920, C_KPE = 2048, C_U = 2176, C_VS = 2432;

constexpr long O_YP = 0, O_YS = 4194304, O_NAK = 6291456, O_NAV = 10485760, O_DK = 14680064, O_DV = 18874368, O_CKV = 23068672, O_KPE = 25165824;

constexpr size_t al256(size_t x) { return (x + 255) & ~(size_t)255; }
constexpr size_t W_WIN = 0;
constexpr size_t W_WOUT = W_WIN + al256((size_t)NL * INP * DM * 2);
constexpr size_t W_WFF1 = W_WOUT + al256((size_t)NL * DM * DM * 2);
constexpr size_t W_WFF2 = W_WFF1 + al256((size_t)NL * FF * DM * 2);
constexpr size_t W_UKVR = W_WFF2 + al256((size_t)NL * DM * FF * 2);
constexpr size_t W_UKVG = W_UKVR + al256((size_t)NL * 512 * 128 * 2);
constexpr size_t W_SGUW = W_UKVG + al256((size_t)NL * 512 * 128 * 2);
constexpr size_t W_X = W_SGUW + al256((size_t)NL * 4 * 128 * 128 * 2);
constexpr size_t W_XA = W_X + al256((size_t)NT * DM * 4);
constexpr size_t W_SS = W_XA + al256((size_t)NT * DM * 2);
constexpr size_t W_QKV = W_SS + al256((size_t)NT * 16 * 4);
constexpr size_t W_O = W_QKV + al256((size_t)NT * INP * 2);
constexpr size_t W_HID = W_O + al256((size_t)NT * DM * 2);
constexpr size_t W_KNOPE = W_HID + al256((size_t)NT * FF * 2);
constexpr size_t W_VT = W_KNOPE + al256((size_t)NT * 256 * 2);
constexpr size_t W_VGT = W_VT + al256((size_t)3 * NT * 256 * 2);
constexpr size_t W_CKA = W_VGT + al256((size_t)NT * 256 * 2);
constexpr size_t W_CVTA = W_CKA + al256((size_t)1048576 * 2);
constexpr size_t W_CKB = W_CVTA + al256((size_t)1048576 * 2);
constexpr size_t W_CVTB = W_CKB + al256((size_t)1048576 * 2);
constexpr size_t W_CKPE = W_CVTB + al256((size_t)1048576 * 2);
constexpr size_t W_CCKV = W_CKPE + al256((size_t)131072 * 2);
constexpr size_t W_CKNOPE = W_CCKV + al256((size_t)524288 * 2);
constexpr size_t W_CVTC = W_CKNOPE + al256((size_t)1048576 * 2);
constexpr size_t W_ADAP = W_CVTC + al256((size_t)1048576 * 2);
constexpr size_t W_E = W_ADAP + al256((size_t)NL * 16 * 3 * 6144 * 4);
constexpr size_t W_SHIN = W_E + al256((size_t)NL * 3 * 6144 * 4);
constexpr size_t W_SHFF = W_SHIN + al256((size_t)NL * 3 * INP * 4);
constexpr size_t W_ROPE = W_SHFF + al256((size_t)NL * 3 * FF * 4);
constexpr size_t W_BAR = W_ROPE + al256(64 * 8 * 8);
constexpr size_t W_CNT = W_BAR + al256(3456 * 4);
constexpr size_t W_END = W_CNT + 1024;

struct Params {
  const float *x_prompt, *x_sample, *c_na_k, *c_na_v, *c_diff_k, *c_diff_v, *c_mla_ckv, *c_mla_kpe, *c, *c_ctx;
  const float *w_ada, *b_ada, *g_mix, *g_ffn, *w_in, *w_out, *na_rpb, *lq1, *lk1, *lq2, *lk2, *g_subln, *g_ckv, *w_uk, *w_uv;
  const float *sgu_g, *sgu_w, *sgu_b, *w_ff1, *w_ff2, *g_final;
  float* out;
  char* ws;
};

DEV u16 f2bf(float f) { unsigned u = __builtin_bit_cast(unsigned, f); return (u16)((u + 0x7fffu + ((u >> 16) & 1u)) >> 16); }
typedef __bf16 bf16x2_t __attribute__((ext_vector_type(2)));
typedef float f32x2_t __attribute__((ext_vector_type(2)));
DEV unsigned pk2(float lo, float hi) { f32x2_t v = {lo, hi}; bf16x2_t b = __builtin_convertvector(v, bf16x2_t); return __builtin_bit_cast(unsigned, b); }
DEV float bf2f(u16 h) { return __builtin_bit_cast(float, (unsigned)h << 16); }
DEV float bflo(unsigned w) { return __builtin_bit_cast(float, w << 16); }
DEV float bfhi(unsigned w) { return __builtin_bit_cast(float, w & 0xffff0000u); }
DEV float gelu_t(float x) { float u = 0.7978845608028654f * (x + 0.044715f * x * x * x); float e = __expf(2.f * u); float t = 1.f - 2.f / (e + 1.f); return 0.5f * x * (1.f + t); }
DEV float ex2(float x) { return __builtin_amdgcn_exp2f(x); }
DEV bf16x8 ld16(const u16* p) { return *reinterpret_cast<const bf16x8*>(p); }
DEV bf16x4 ld8(const u16* p) { return *reinterpret_cast<const bf16x4*>(p); }
DEV void st_pk4(u16* p, float a, float b, float c, float d) { uint2 v; v.x = pk2(a, b); v.y = pk2(c, d); *reinterpret_cast<uint2*>(p) = v; }
DEV int opaque_tid(int wv) { int t = (wv << 6) | (int)__builtin_amdgcn_mbcnt_hi(~0u, __builtin_amdgcn_mbcnt_lo(~0u, 0u)); asm volatile("" : "+v"(t)); return t; }
DEV int ridx_of_mt(int mt) { return mt < 16 ? 0 : 1 + ((mt - 16) >> 2); }
DEV float xrow16_max(float x) {
  auto s = __builtin_amdgcn_permlane16_swap(__float_as_uint(x), __float_as_uint(x), false, false);
  x = fmaxf(__uint_as_float(s[0]), __uint_as_float(s[1]));
  auto t = __builtin_amdgcn_permlane32_swap(__float_as_uint(x), __float_as_uint(x), false, false);
  return fmaxf(__uint_as_float(t[0]), __uint_as_float(t[1]));
}
DEV float xrow16_sum(float x) {
  auto s = __builtin_amdgcn_permlane16_swap(__float_as_uint(x), __float_as_uint(x), false, false);
  x = __uint_as_float(s[0]) + __uint_as_float(s[1]);
  auto t = __builtin_amdgcn_permlane32_swap(__float_as_uint(x), __float_as_uint(x), false, false);
  return __uint_as_float(t[0]) + __uint_as_float(t[1]);
}
DEV float red16(float v) { v += __shfl_xor(v, 1); v += __shfl_xor(v, 2); v += __shfl_xor(v, 4); v += __shfl_xor(v, 8); return v; }
DEV float wave_sum(float v) { v = red16(v); v += __shfl_xor(v, 16); v += __shfl_xor(v, 32); return v; }

constexpr int NTHR = 512;
constexpr int GSTG = 49152, GBO = 32768, LSCR = 3 * 49152, LBARW = LSCR + 1024, LQSLOT = LBARW + 32, LDS_BYTES = LBARW + 64;
DEV void stage_rc(int b, int& R, int& C) { int st = b / 1024, sb = b % 1024, swz = sb ^ (((sb >> 9) & 1) << 5); R = (st >> 1) * 16 + swz / 64; C = (st & 1) * 32 + (swz % 64) / 2; }

template <int NI>
DEV void stage_tile(char* dst, const u16* src, const int (&off)[4], int tid) {
#pragma unroll
  for (int i = 0; i < NI; ++i) {
    int b = tid * 16 + i * 8192;
    __builtin_amdgcn_global_load_lds((const unsigned*)(src + off[i]), (__attribute__((address_space(3))) unsigned*)(dst + b), 16, 0, 0);
  }
}

template <int MT, int NTW, int NSTG, class Prob, class Epi>
DEV void gemm_phase(char* lds, const Prob& prob, const Epi& epi, int wv) {
  constexpr int NB = NTW / 2;
  constexpr int SSTR = (NTW == 8) ? 65536 : GSTG;
  const int tid = opaque_tid(wv), lane = tid & 63, wr = wv >> 1, wc = wv & 1, fr = lane & 15, fq = lane >> 4;
  int offA[4], offB[4];
#pragma unroll
  for (int i = 0; i < 4; ++i) { int R, C; stage_rc(tid * 16 + i * 8192, R, C); offA[i] = R * prob.lda + C; offB[i] = R * prob.ldb + C; }
  const int lo = (fr * 64 + fq * 16) ^ (((fr >> 3) & 1) << 5);
  const int nk = prob.K / 64;
  const int ntiles = prob.ntiles();
  for (int tile = blockIdx.x; tile < ntiles; tile += gridDim.x) {
    const u16 *Ab, *Bb; int mt, nt;
    prob.get(tile, Ab, Bb, mt, nt);
    f32x4 acc[MT][NTW];
#pragma unroll
    for (int m = 0; m < MT; ++m)
#pragma unroll
      for (int n = 0; n < NTW; ++n) acc[m][n] = f32x4{0.f, 0.f, 0.f, 0.f};
#pragma unroll
    for (int sg = 0; sg < NSTG - 1; ++sg) { stage_tile<MT>(lds + sg * SSTR, Ab + sg * 64, offA, tid); stage_tile<NB>(lds + sg * SSTR + GBO, Bb + sg * 64, offB, tid); }
    epi.pre((float*)(lds + LSCR), mt, nt, tid);
    typename Epi::Regs er; epi.preload(er, mt, nt, wr, wc, fr, fq);
    int sc = 0;
    for (int t = 0; t < nk; ++t) {
      if (NSTG == 3 && t + 1 < nk) { if (MT + NB == 6) asm volatile("s_waitcnt vmcnt(6)" ::: "memory"); else asm volatile("s_waitcnt vmcnt(5)" ::: "memory"); }
      else asm volatile("s_waitcnt vmcnt(0)" ::: "memory");
      __builtin_amdgcn_s_barrier();
      asm volatile("" ::: "memory");
      char* cur = lds + sc * SSTR;
      if (t + NSTG - 1 < nk) { int sn = sc + NSTG - 1; if (sn >= NSTG) sn -= NSTG; char* nxt = lds + sn * SSTR; stage_tile<MT>(nxt, Ab + (t + NSTG - 1) * 64, offA, tid); stage_tile<NB>(nxt + GBO, Bb + (t + NSTG - 1) * 64, offB, tid); }
      sc = (sc == NSTG - 1) ? 0 : sc + 1;
      bf16x8 af[MT][2];
#pragma unroll
      for (int m = 0; m < MT; ++m) af[m][0] = *reinterpret_cast<const bf16x8*>(cur + ((wr * MT + m) * 2 + 0) * 1024 + lo);
#pragma unroll
      for (int nh = 0; nh < NTW / 4; ++nh) {
        bf16x8 bfr[4][2];
#pragma unroll
        for (int n = 0; n < 4; ++n) bfr[n][0] = *reinterpret_cast<const bf16x8*>(cur + GBO + ((wc * NTW + nh * 4 + n) * 2 + 0) * 1024 + lo);
        __builtin_amdgcn_sched_barrier(0);
        if (nh == 0) {
#pragma unroll
          for (int m = 0; m < MT; ++m) af[m][1] = *reinterpret_cast<const bf16x8*>(cur + ((wr * MT + m) * 2 + 1) * 1024 + lo);
        }
#pragma unroll
        for (int n = 0; n < 4; ++n) bfr[n][1] = *reinterpret_cast<const bf16x8*>(cur + GBO + ((wc * NTW + nh * 4 + n) * 2 + 1) * 1024 + lo);
#pragma unroll
        for (int m = 0; m < MT; ++m)
#pragma unroll
          for (int n = 0; n < 4; ++n) acc[m][nh * 4 + n] = __builtin_amdgcn_mfma_f32_16x16x32_bf16(af[m][0], bfr[n][0], acc[m][nh * 4 + n], 0, 0, 0);
        if (nh == 0) {
#pragma unroll
          for (int q = 0; q < MT + 4; ++q) {
            __builtin_amdgcn_sched_group_barrier(0x008, 1, 0);
            __builtin_amdgcn_sched_group_barrier(0x100, 1, 0);
          }
          __builtin_amdgcn_sched_group_barrier(0x008, MT * 4 - (MT + 4), 0);
        } else {
#pragma unroll
          for (int q = 0; q < 4; ++q) {
            __builtin_amdgcn_sched_group_barrier(0x008, 1, 0);
            __builtin_amdgcn_sched_group_barrier(0x100, 1, 0);
          }
          __builtin_amdgcn_sched_group_barrier(0x008, MT * 4 - 4, 0);
        }
        __builtin_amdgcn_sched_barrier(0);
#pragma unroll
        for (int m = 0; m < MT; ++m)
#pragma unroll
          for (int n = 0; n < 4; ++n) acc[m][nh * 4 + n] = __builtin_amdgcn_mfma_f32_16x16x32_bf16(af[m][1], bfr[n][1], acc[m][nh * 4 + n], 0, 0, 0);
        __builtin_amdgcn_sched_barrier(0);
      }
    }
    { int wr2 = wr, wc2 = wc, fr2 = fr, fq2 = fq; asm volatile("" : "+v"(fr2), "+v"(fq2), "+s"(wr2), "+s"(wc2));
      epi.run(acc, er, (const float*)(lds + LSCR), mt, nt, wr2, wc2, fr2, fq2); }
    __syncthreads();
  }
}

struct ProbStd {
  const u16* A; const u16* Bt; int lda, ldb, K, nMt, nNt, bm, bn;
  DEV int ntiles() const { return nMt * nNt; }
  DEV void get(int tile, const u16*& Ab, const u16*& Bb, int& mt, int& nt) const {
    mt = tile % nMt; nt = tile / nMt; Ab = A + (long)mt * bm * lda; Bb = Bt + (long)nt * bn * ldb;
  }
};
struct ProbCache {
  const u16* A; const u16* Bt; int lda, ldb, K;
  DEV int ntiles() const { return 16 * 4; }
  DEV void get(int tile, const u16*& Ab, const u16*& Bb, int& mt, int& nt) const {
    mt = tile & 15; nt = tile >> 4; int l = (mt >> 1) & 3; Ab = A + (long)mt * 256 * lda; Bb = Bt + (long)l * 512 * 128 + (long)nt * 128 * ldb;
  }
};

DEV void pre_rstd(float* s, const float* ss, int mt, int tid) {
  if (tid < 256) {
    const float4* p = reinterpret_cast<const float4*>(ss + (long)(mt * 256 + tid) * 16);
    float4 a = p[0], b = p[1], c = p[2], d = p[3];
    float t = (a.x + a.y + a.z + a.w) + (b.x + b.y + b.z + b.w) + (c.x + c.y + c.z + c.w) + (d.x + d.y + d.z + d.w);
    s[tid] = rsqrtf(t * (1.f / 1024.f) + 1e-6f);
  }
  __syncthreads();
}

struct EpiIn {
  struct Regs {}; DEV void preload(Regs&, int, int, int, int, int, int) const {}
  const float* ss; const float* shW;
  u16* qkv; u16* vt; u16* vgt; const float2* rope; const float* sgu_g;
  float* out; int l;
  DEV void pre(float* s, int mt, int, int tid) const { pre_rstd(s, ss, mt, tid); }
  DEV void run(const f32x4 (&acc)[4][4], const Regs&, const float* s, int mt, int nt, int wr, int wc, int fr, int fq) const {
    const int ridx = ridx_of_mt(mt);
    const float* sh = shW + ridx * INP;
    const int wcb = nt * 128 + wc * 64;
    const bool sample = mt >= 16;
    float shq[4];
#pragma unroll
    for (int n = 0; n < 4; ++n) shq[n] = sh[wcb + n * 16 + fr];
    if (wcb >= C_VS) {
      const int g = (wcb - C_VS) >> 6;
      float ggq[4];
#pragma unroll
      for (int n = 0; n < 4; ++n) ggq[n] = sgu_g[g * 64 + n * 16 + fr];
      __builtin_amdgcn_sched_barrier(0);
#pragma unroll
      for (int m = 0; m < 4; ++m) {
        const int rl = wr * 64 + m * 16 + fq * 4;
        float v[4][4], sq[4] = {0.f, 0.f, 0.f, 0.f};
#pragma unroll
        for (int n = 0; n < 4; ++n) {
          float shv = shq[n];
#pragma unroll
          for (int j = 0; j < 4; ++j) { float x = gelu_t(s[rl + j] * acc[m][n][j] + shv); v[n][j] = x; sq[j] += x * x; }
        }
#pragma unroll
        for (int j = 0; j < 4; ++j) sq[j] = rsqrtf(red16(sq[j]) * (1.f / 64.f) + 1e-6f);
#pragma unroll
        for (int n = 0; n < 4; ++n) {
          int c = n * 16 + fr; float gg = ggq[n];
          st_pk4(vgt + ((long)(((mt * 2 + (rl >> 7)) * 4 + g) * 64 + c)) * 128 + (rl & 127), v[n][0] * sq[0] * gg, v[n][1] * sq[1] * gg, v[n][2] * sq[2] * gg, v[n][3] * sq[3] * gg);
        }
      }
      return;
    }
#pragma unroll
    for (int n = 0; n < 4; ++n) {
      const int cb = wcb + n * 16, col = cb + fr;
      if (cb >= 2080 && cb < C_U) continue;
      const float shv = shq[n];
      const bool isU = cb >= C_U;
      const bool ropeR = (cb >= C_QB && cb < C_VB) || (cb >= C_KPE) || (cb >= C_QC && cb < C_CKV && ((cb - C_QC) % 96) >= 64);
      const bool isVA = (cb >= C_VA && cb < C_QB), isVB = (cb >= C_VB && cb < C_QC);
      float2 csq[4][4];
      if (sample && ropeR) {
        const int i8 = fr & 7; const bool colg = (cb >> 4) & 1;
#pragma unroll
        for (int m = 0; m < 4; ++m)
#pragma unroll
          for (int j = 0; j < 4; ++j) { int t = (mt * 256 + wr * 64 + m * 16 + fq * 4 + j - NP) & 1023; int pos = colg ? (t & 63) : (t >> 6); csq[m][j] = rope[pos * 8 + i8]; }
        __builtin_amdgcn_sched_barrier(0);
      }
#pragma unroll
      for (int m = 0; m < 4; ++m) {
        const int rl = wr * 64 + m * 16 + fq * 4;
        const int row = mt * 256 + rl;
        float v[4];
#pragma unroll
        for (int j = 0; j < 4; ++j) v[j] = s[rl + j] * acc[m][n][j] + shv;
        if (isU) {
#pragma unroll
          for (int j = 0; j < 4; ++j) qkv[(long)(row + j) * INP + col] = f2bf(gelu_t(v[j]));
          continue;
        }
        if (sample && ropeR) {
#pragma unroll
          for (int j = 0; j < 4; ++j) {
            float2 cs = csq[m][j];
            float pr = __shfl_xor(v[j], 8);
            v[j] = (fr < 8) ? (v[j] * cs.x - pr * cs.y) : (v[j] * cs.x + pr * cs.y);
          }
        }
        if (isVA || isVB) {
          int cc = col - (isVA ? C_VA : C_VB); int h = cc >> 6, d = cc & 63;
          u16* base = vt + (isVA ? 0 : (long)NT * 256);
          if (!sample) { int b = row >> 8, sidx = row & 255; st_pk4(base + ((long)((b * 4 + h) * 64 + d)) * 256 + sidx, v[0], v[1], v[2], v[3]); }
          else { int b = (row - NP) >> 10, sidx = (row - NP) & 1023; st_pk4(base + (long)NP * 256 + ((long)((b * 4 + h) * 64 + d)) * 1024 + sidx, v[0], v[1], v[2], v[3]); }
        } else {
#pragma unroll
          for (int j = 0; j < 4; ++j) qkv[(long)(row + j) * INP + col] = f2bf(v[j]);
        }
        if (!sample) {
          const int b = row >> 8, sidx = row & 255;
          long ob = -1; int cc = 0;
          if (cb >= C_KA && cb < C_VA) { ob = O_NAK; cc = col - C_KA; }
          else if (isVA) { ob = O_NAV; cc = col - C_VA; }
          else if (cb >= C_KB && cb < C_VB) { ob = O_DK; cc = col - C_KB; }
          else if (isVB) { ob = O_DV; cc = col - C_VB; }
          if (ob >= 0) {
            int h = cc >> 6, d = cc & 63;
            float* o = out + ob + ((long)(((b * 4 + l) * 4 + h) * 256 + sidx)) * 64 + d;
#pragma unroll
            for (int j = 0; j < 4; ++j) __builtin_nontemporal_store(v[j], o + j * 64);
          } else if (cb >= C_KPE) {
            float* o = out + O_KPE + ((long)((b * 4 + l) * 256 + sidx)) * 32 + (col - C_KPE);
#pragma unroll
            for (int j = 0; j < 4; ++j) __builtin_nontemporal_store(v[j], o + j * 32);
          }
        }
      }
    }
  }
};

struct EpiRes {
  float* x; u16* xa; float* ss; const float* gate;
  const float* gnext; const float* scnext;
  int dry;
  DEV void pre(float*, int, int, int) const {}
  struct Regs { float xr[3][4][4], gt[3][4], an[3][4]; };
  DEV void preload(Regs& r, int mt, int nt, int wr, int wc, int fr, int fq) const {
    const int wcb = nt * 128 + wc * 64;
#pragma unroll
    for (int m = 0; m < 3; ++m) {
      const int row = mt * 192 + wr * 48 + m * 16 + fq * 4;
      const int r16 = mt * 192 + wr * 48 + m * 16;
      const int ridx = (r16 < NP) ? 0 : 1 + ((r16 - NP) >> 10);
#pragma unroll
      for (int n = 0; n < 4; ++n) {
        const int col = wcb + n * 16 + fr;
        r.gt[m][n] = gate[ridx * 6144 + col];
        r.an[m][n] = gnext ? gnext[col] * (1.f + scnext[ridx * 6144 + col]) : 0.f;
#pragma unroll
        for (int j = 0; j < 4; ++j) r.xr[m][n][j] = x[(long)(row + j) * DM + col];
      }
    }
  }
  DEV void run(const f32x4 (&acc)[3][4], const Regs& r, const float*, int mt, int nt, int wr, int wc, int fr, int fq) const {
    const int wcb = nt * 128 + wc * 64;
#pragma unroll
    for (int m = 0; m < 3; ++m) {
      const int row = mt * 192 + wr * 48 + m * 16 + fq * 4;
      float sq[4] = {0.f, 0.f, 0.f, 0.f};
#pragma unroll
      for (int n = 0; n < 4; ++n) {
        const int col = wcb + n * 16 + fr;
#pragma unroll
        for (int j = 0; j < 4; ++j) {
          const long idx = (long)(row + j) * DM + col;
          const float xv = r.xr[m][n][j] + r.gt[m][n] * acc[m][n][j];
          if (!dry) x[idx] = xv; xa[idx] = f2bf(xv * r.an[m][n]); sq[j] += xv * xv;
        }
      }
#pragma unroll
      for (int j = 0; j < 4; ++j) { float t = red16(sq[j]); if (fr == 0) ss[(long)(row + j) * 16 + nt * 2 + wc] = t; }
    }
  }
};

struct EpiFF1 {
  struct Regs {}; DEV void preload(Regs&, int, int, int, int, int, int) const {}
  const float* ss; const float* shW; u16* hid;
  DEV void pre(float* s, int mt, int, int tid) const {
    if (tid < 192) {
      const float4* p = reinterpret_cast<const float4*>(ss + (long)(mt * 192 + tid) * 16);
      float4 a = p[0], b = p[1], c = p[2], d = p[3];
      float t = (a.x + a.y + a.z + a.w) + (b.x + b.y + b.z + b.w) + (c.x + c.y + c.z + c.w) + (d.x + d.y + d.z + d.w);
      s[tid] = rsqrtf(t * (1.f / 1024.f) + 1e-6f);
    }
    __syncthreads();
  }
  DEV void run(const f32x4 (&acc)[3][8], const Regs&, const float* s, int mt, int nt, int wr, int wc, int fr, int fq) const {
    const int wcb = nt * 256 + wc * 128;
    float shq[3][8];
#pragma unroll
    for (int m = 0; m < 3; ++m) {
      const int r16 = mt * 192 + wr * 48 + m * 16;
      const int ridx = (r16 < NP) ? 0 : 1 + ((r16 - NP) >> 10);
#pragma unroll
      for (int n = 0; n < 8; ++n) shq[m][n] = shW[ridx * FF + wcb + n * 16 + fr];
    }
    __builtin_amdgcn_sched_barrier(0);
#pragma unroll
    for (int m = 0; m < 3; ++m) {
      const int rl = wr * 48 + m * 16 + fq * 4; const int row = mt * 192 + rl;
#pragma unroll
      for (int n = 0; n < 8; ++n) {
        int col = wcb + n * 16 + fr; float shv = shq[m][n];
#pragma unroll
        for (int j = 0; j < 4; ++j) { float v = fmaxf(s[rl + j] * acc[m][n][j] + shv, 0.f); hid[(long)(row + j) * FF + col] = f2bf(v * v); }
      }
    }
  }
};

struct EpiUKV {
  struct Regs {}; DEV void preload(Regs&, int, int, int, int, int, int) const {}
  int cache; int l; const u16* qkv; const float* g_ckv; float* out;
  u16* knope; u16* vtc;
  DEV void pre(float* s, int mt, int nt, int tid) const {
    if (cache) { if (tid < 256) s[tid] = 1.f; __syncthreads(); return; }
    int r = tid >> 1, hf = tid & 1; int row = mt * 256 + r;
    const u16* p = qkv + (long)row * INP + C_CKV + hf * 64;
    float v[64]; float sq = 0.f;
#pragma unroll
    for (int i = 0; i < 8; ++i) {
      bf16x8 q = ld16(p + i * 8);
#pragma unroll
      for (int e = 0; e < 8; ++e) { float f = bf2f((u16)q[e]); v[i * 8 + e] = f; sq += f * f; }
    }
    sq += __shfl_xor(sq, 1);
    float rs = rsqrtf(sq * (1.f / 128.f) + 1e-6f);
    if (hf == 0) s[r] = rs;
    if (nt == 0 && mt < 16) {
      int b = row >> 8, sidx = row & 255;
      float* o = out + O_CKV + ((long)((b * 4 + l) * 256 + sidx)) * 128 + hf * 64;
#pragma unroll
      for (int i = 0; i < 16; ++i) {
        float4 w; w.x = v[i * 4] * rs * g_ckv[hf * 64 + i * 4]; w.y = v[i * 4 + 1] * rs * g_ckv[hf * 64 + i * 4 + 1];
        w.z = v[i * 4 + 2] * rs * g_ckv[hf * 64 + i * 4 + 2]; w.w = v[i * 4 + 3] * rs * g_ckv[hf * 64 + i * 4 + 3];
        { typedef float f4v __attribute__((ext_vector_type(4))); f4v ov = {w.x, w.y, w.z, w.w}; __builtin_nontemporal_store(ov, reinterpret_cast<f4v*>(o + i * 4)); }
      }
    }
    __syncthreads();
  }
  DEV void run(const f32x4 (&acc)[4][4], const Regs&, const float* s, int mt, int nt, int wr, int wc, int fr, int fq) const {
    const int wcb = nt * 128 + wc * 64;
#pragma unroll
    for (int n = 0; n < 4; ++n) {
      const int col = wcb + n * 16 + fr;
#pragma unroll
      for (int m = 0; m < 4; ++m) {
        const int rl = wr * 64 + m * 16 + fq * 4; const int row = mt * 256 + rl;
        float v[4];
#pragma unroll
        for (int j = 0; j < 4; ++j) v[j] = s[rl + j] * acc[m][n][j];
        if (wcb < 256) {
#pragma unroll
          for (int j = 0; j < 4; ++j) knope[(long)(row + j) * 256 + col] = f2bf(v[j]);
        } else {
          int h = (col - 256) >> 6, d = col & 63;
          if (cache) { int bl = row >> 9, key = row & 511; st_pk4(vtc + ((long)((bl * 4 + h) * 64 + d)) * 512 + key, v[0], v[1], v[2], v[3]); }
          else if (mt < 16) { int b = row >> 8, sidx = row & 255; st_pk4(vtc + ((long)((b * 4 + h) * 64 + d)) * 256 + sidx, v[0], v[1], v[2], v[3]); }
          else { int b = (row - NP) >> 10, sidx = (row - NP) & 1023; st_pk4(vtc + (long)NP * 256 + ((long)((b * 4 + h) * 64 + d)) * 1024 + sidx, v[0], v[1], v[2], v[3]); }
        }
      }
    }
  }
};

template <int MODE> struct AttnSt { static constexpr int NSM = (MODE == 1) ? 2 : 1; f32x4 O[NSM][4]; float m[NSM], l[NSM]; };
constexpr int AK0 = 0, AK1 = 13312, AV0 = 26624, AV1 = 35840, VSTR = 144;
struct TileSrc { const u16* K; const u16* Pe; const u16* Vt; int ldk, ldpe, ldv; };
DEV const u16* k_src(const TileSrc& s, int c, bool mla) {
  if (mla) { int row = c / 12, cc = c % 12; return (cc < 8) ? (s.K + (long)row * s.ldk + cc * 8) : (s.Pe + (long)row * s.ldpe + (cc - 8) * 8); }
  int row = c >> 3, cc = c & 7; return s.K + (long)row * s.ldk + cc * 8;
}
DEV int k_dst(int c, bool mla) { if (mla) { int row = c / 12, cc = c % 12; return row * 208 + cc * 16; } int row = c >> 3, cc = c & 7; return row * 144 + cc * 16; }
template <int MODE> DEV void stage_load(uint4& k0, uint4& k1, uint4& v0, const TileSrc& s, int tid) {
  k0 = *reinterpret_cast<const uint4*>(k_src(s, tid, MODE == 2));
  if (MODE == 2) { if (tid < 256) k1 = *reinterpret_cast<const uint4*>(k_src(s, tid + 512, true)); }
  { int d = tid >> 3, cc = tid & 7; v0 = *reinterpret_cast<const uint4*>(s.Vt + (long)d * s.ldv + cc * 8); }
}
template <int MODE> DEV void stage_store(const uint4& k0, const uint4& k1, const uint4& v0, char* kbuf, char* vbuf, int tid) {
  *reinterpret_cast<uint4*>(kbuf + k_dst(tid, MODE == 2)) = k0;
  if (MODE == 2) { if (tid < 256) *reinterpret_cast<uint4*>(kbuf + k_dst(tid + 512, true)) = k1; }
  { int d = tid >> 3, cc = tid & 7; *reinterpret_cast<uint4*>(vbuf + d * VSTR + cc * 16) = v0; }
}

template <int MODE>
DEV void attn_compute(AttnSt<MODE>& st, const bf16x8* qf, const char* kbuf, const char* vbuf, float sc, int fr, int fq, bool na, const float* rpbrow, int cq) {
  constexpr int NSM = AttnSt<MODE>::NSM; constexpr int KSTR = (MODE == 2) ? 208 : 144;
  f32x4 s[NSM][4];
  constexpr int KS = (MODE == 2) ? 3 : 2;
  bf16x8 kf[4][KS];
#pragma unroll
  for (int t = 0; t < 4; ++t) {
    const char* kr = kbuf + (16 * t + fr) * KSTR + fq * 16;
#pragma unroll
    for (int ks = 0; ks < KS; ++ks) kf[t][ks] = *reinterpret_cast<const bf16x8*>(kr + 64 * ks);
  }
  __builtin_amdgcn_sched_barrier(0);
#pragma unroll
  for (int t = 0; t < 4; ++t) {
    f32x4 z = {0.f, 0.f, 0.f, 0.f};
    if (MODE == 1) {
      s[0][t] = __builtin_amdgcn_mfma_f32_16x16x32_bf16(kf[t][0], qf[0], z, 0, 0, 0);
      s[NSM - 1][t] = __builtin_amdgcn_mfma_f32_16x16x32_bf16(kf[t][1], qf[1], z, 0, 0, 0);
    } else {
      s[0][t] = __builtin_amdgcn_mfma_f32_16x16x32_bf16(kf[t][0], qf[0], z, 0, 0, 0);
      s[0][t] = __builtin_amdgcn_mfma_f32_16x16x32_bf16(kf[t][1], qf[1], s[0][t], 0, 0, 0);
      if (MODE == 2) s[0][t] = __builtin_amdgcn_mfma_f32_16x16x32_bf16(kf[t][KS - 1], qf[2], s[0][t], 0, 0, 0);
    }
  }
  bf16x8 vfr[2][4];
#pragma unroll
  for (int hh = 0; hh < 2; ++hh)
#pragma unroll
    for (int dt = 0; dt < 4; ++dt) {
      const char* vr = vbuf + (dt * 16 + fr) * VSTR + 8 * fq;
      bf16x4 v0 = *reinterpret_cast<const bf16x4*>(vr + 32 * (2 * hh)), v1 = *reinterpret_cast<const bf16x4*>(vr + 32 * (2 * hh + 1));
      vfr[hh][dt] = bf16x8{v0[0], v0[1], v0[2], v0[3], v1[0], v1[1], v1[2], v1[3]};
    }
  __builtin_amdgcn_sched_barrier(0);
#pragma unroll
  for (int x = 0; x < NSM; ++x) {
    float mx;
    if (MODE == 0 && na) {
      mx = -1e30f;
      int fr2 = fr, fq2 = fq; asm volatile("" : "+v"(fr2), "+v"(fq2));
      const int cqq = cq + fr2; const int c0 = min(max(cqq - 8, 0), 48);
      float bq[4][4];
#pragma unroll
      for (int t = 0; t < 4; ++t)
#pragma unroll
        for (int j = 0; j < 4; ++j) { int ck = 16 * t + 4 * fq2 + j; int bi = min(max(ck - cqq + 15, 0), 30); bq[t][j] = rpbrow[bi]; }
#pragma unroll
      for (int t = 0; t < 4; ++t)
#pragma unroll
        for (int j = 0; j < 4; ++j) {
          int ck = 16 * t + 4 * fq2 + j;
          bool valid = (ck >= c0) && (ck < c0 + 16);
          float v = valid ? __builtin_fmaf(bq[t][j], 1.4426950408889634f, s[x][t][j] * sc) : -1e30f;
          s[x][t][j] = v; mx = fmaxf(mx, v);
        }
    } else {
      float r = -3e38f;
#pragma unroll
      for (int t = 0; t < 4; ++t)
#pragma unroll
        for (int j = 0; j < 4; ++j) r = fmaxf(r, s[x][t][j]);
      mx = r * sc;
    }
    mx = xrow16_max(mx);
    const float mnew = fmaxf(st.m[x], mx); const float alpha = ex2(st.m[x] - mnew); st.m[x] = mnew;
    float ps = 0.f;
    if (MODE == 0 && na) {
#pragma unroll
      for (int t = 0; t < 4; ++t)
#pragma unroll
        for (int j = 0; j < 4; ++j) { float p = ex2(s[x][t][j] - mnew); s[x][t][j] = p; ps += p; }
    } else {
#pragma unroll
      for (int t = 0; t < 4; ++t)
#pragma unroll
        for (int j = 0; j < 4; ++j) { float p = ex2(__builtin_fmaf(s[x][t][j], sc, -mnew)); s[x][t][j] = p; ps += p; }
    }
    st.l[x] = st.l[x] * alpha + ps;
    if (__builtin_amdgcn_ballot_w64(alpha != 1.f) != 0ull) {
#pragma unroll
      for (int dt = 0; dt < 4; ++dt) st.O[x][dt] *= alpha;
    }
  }
#pragma unroll
  for (int hh = 0; hh < 2; ++hh) {
    const int t0 = 2 * hh, t1 = 2 * hh + 1;
    bf16x8 pf[NSM];
#pragma unroll
    for (int x = 0; x < NSM; ++x) {
      uint4 u = {pk2(s[x][t0][0], s[x][t0][1]), pk2(s[x][t0][2], s[x][t0][3]), pk2(s[x][t1][0], s[x][t1][1]), pk2(s[x][t1][2], s[x][t1][3])};
      pf[x] = __builtin_bit_cast(bf16x8, u);
    }
#pragma unroll
    for (int dt = 0; dt < 4; ++dt) {
#pragma unroll
      for (int x = 0; x < NSM; ++x) st.O[x][dt] = __builtin_amdgcn_mfma_f32_16x16x32_bf16(vfr[hh][dt], pf[x], st.O[x][dt], 0, 0, 0);
    }
  }
}

template <int MODE> DEV void attn_init(AttnSt<MODE>& st) {
#pragma unroll
  for (int x = 0; x < AttnSt<MODE>::NSM; ++x) {
    st.m[x] = -1e30f; st.l[x] = 0.f;
#pragma unroll
    for (int dt = 0; dt < 4; ++dt) st.O[x][dt] = f32x4{0.f, 0.f, 0.f, 0.f};
  }
}
DEV float red_fq(float v) { return xrow16_sum(v); }

template <int MODE, class SrcFn>
DEV void attn_run(char* lds, AttnSt<MODE>& st, const bf16x8* qf, int ntiles, const SrcFn& src, float sc, int tid, int na_from, int na_lo, int na_hi, const float* rpbh, int drow0, int cq) {
  const int lane = tid & 63, fr = lane & 15, fq = lane >> 4;
  uint4 ak0, ak1 = {0u, 0u, 0u, 0u}, av0, bk0, bk1 = {0u, 0u, 0u, 0u}, bv0;
  { TileSrc s = src(0); stage_load<MODE>(ak0, ak1, av0, s, tid); stage_store<MODE>(ak0, ak1, av0, lds + AK0, lds + AV0, tid); }
  if (ntiles > 1) { TileSrc s = src(1); stage_load<MODE>(bk0, bk1, bv0, s, tid); }
  __syncthreads();
  for (int i = 0; i < ntiles; i += 2) {
    {
      if (i + 2 < ntiles) { TileSrc s = src(i + 2); stage_load<MODE>(ak0, ak1, av0, s, tid); }
      const bool na = (MODE == 0) && (i >= na_from);
      if (!na || (i >= na_lo && i < na_hi))
        attn_compute<MODE>(st, qf, lds + AK0, lds + AV0, sc, fr, fq, na, rpbh + (long)(drow0 + i) * 31, cq);
      if (i + 1 < ntiles) stage_store<MODE>(bk0, bk1, bv0, lds + AK1, lds + AV1, tid);
      __syncthreads();
    }
    if (i + 1 < ntiles) {
      const int i1 = i + 1;
      if (i1 + 2 < ntiles) { TileSrc s = src(i1 + 2); stage_load<MODE>(bk0, bk1, bv0, s, tid); }
      const bool na = (MODE == 0) && (i1 >= na_from);
      if (!na || (i1 >= na_lo && i1 < na_hi))
        attn_compute<MODE>(st, qf, lds + AK1, lds + AV1, sc, fr, fq, na, rpbh + (long)(drow0 + i1) * 31, cq);
      if (i1 + 1 < ntiles) stage_store<MODE>(ak0, ak1, av0, lds + AK0, lds + AV0, tid);
      __syncthreads();
    }
  }
}

struct MixCtx {
  const Params* p; int l; const u16 *qkv, *knope, *vt, *vgt; u16* obuf;
  const u16 *cKa, *cVtA, *cKb, *cVtB, *cKpe, *cKnope, *cVtC, *sguW;
};

DEV void fin_std(const AttnSt<0>& st, u16* o, int fq) {
  float il = 1.f / red_fq(st.l[0]);
#pragma unroll
  for (int dt = 0; dt < 4; ++dt) st_pk4(o + dt * 16 + 4 * fq, st.O[0][dt][0] * il, st.O[0][dt][1] * il, st.O[0][dt][2] * il, st.O[0][dt][3] * il);
}
DEV void fin_mla(const AttnSt<2>& st, u16* o, int fq) {
  float il = 1.f / red_fq(st.l[0]);
#pragma unroll
  for (int dt = 0; dt < 4; ++dt) st_pk4(o + dt * 16 + 4 * fq, st.O[0][dt][0] * il, st.O[0][dt][1] * il, st.O[0][dt][2] * il, st.O[0][dt][3] * il);
}
DEV void fin_diff(const AttnSt<1>& st, u16* o, int fq, int lane, const Params& p, int l) {
  float lam_init = 0.8f - 0.6f * expf(-0.3f * (float)l);
  float d1 = (lane < 32) ? p.lq1[l * 32 + lane] * p.lk1[l * 32 + lane] : 0.f, d2 = (lane < 32) ? p.lq2[l * 32 + lane] * p.lk2[l * 32 + lane] : 0.f;
  float lam = expf(wave_sum(d1)) - expf(wave_sum(d2)) + lam_init;
  float i1 = 1.f / red_fq(st.l[0]), i2 = lam / red_fq(st.l[1]);
  float o4[4][4], sq = 0.f;
#pragma unroll
  for (int dt = 0; dt < 4; ++dt)
#pragma unroll
    for (int j = 0; j < 4; ++j) { float v = st.O[0][dt][j] * i1 - st.O[1][dt][j] * i2; o4[dt][j] = v; sq += v * v; }
  float rs = rsqrtf(red_fq(sq) * (1.f / 64.f) + 1e-6f) * (1.f - lam_init);
#pragma unroll
  for (int dt = 0; dt < 4; ++dt) {
    const float* g = p.g_subln + l * 64 + dt * 16 + 4 * fq;
    st_pk4(o + dt * 16 + 4 * fq, o4[dt][0] * rs * g[0], o4[dt][1] * rs * g[1], o4[dt][2] * rs * g[2], o4[dt][3] * rs * g[3]);
  }
}

constexpr int MIX_BLOCK_ITEMS = 64 * 3 + 128 * 3 + 192;

DEV void mixer_block_item(char* lds, const MixCtx& M, int it, int tid) {
  const int lane = tid & 63, w = __builtin_amdgcn_readfirstlane(tid >> 6), fr = lane & 15, fq = lane >> 4;
  const Params& p = *M.p; const int l = M.l;
  const float L2E = 1.4426950408889634f;
  const u16* vtA = M.vt; const u16* vtB = M.vt + (long)NT * 256; const u16* vtC = M.vt + (long)2 * NT * 256;
  if (it < 64) {
    int b = it >> 5, h = (it >> 3) & 3, qt = it & 7;
    int row = NP + b * 1024 + qt * 128 + w * 16 + fr;
    bf16x8 qf[2]; qf[0] = ld16(M.qkv + (long)row * INP + C_QB + h * 64 + fq * 8); qf[1] = ld16(M.qkv + (long)row * INP + C_QB + h * 64 + 32 + fq * 8);
    AttnSt<1> st; attn_init<1>(st);
    const int bl = (b * 4 + l) * 4 + h;
    const u16* ck = M.cKb + (long)bl * 512 * 64; const u16* cv = M.cVtB + (long)bl * 64 * 512;
    const u16* nk = M.qkv + (long)(NP + b * 1024) * INP + C_KB + h * 64; const u16* nv = vtB + (long)NP * 256 + (long)((b * 4 + h) * 64) * 1024;
    auto src = [&](int i) { TileSrc s; if (i < 8) { s.K = ck + (long)i * 64 * 64; s.ldk = 64; s.Vt = cv + i * 64; s.ldv = 512; } else { int j = i - 8; s.K = nk + (long)j * 64 * INP; s.ldk = INP; s.Vt = nv + j * 64; s.ldv = 1024; } s.Pe = nullptr; s.ldpe = 0; return s; };
    attn_run<1>(lds, st, qf, 24, src, 0.17677669529663687f * L2E, tid, 1000, 0, 0, p.na_rpb, 0, 0);
    fin_diff(st, M.obuf + (long)row * DM + 256 + h * 64, fq, lane, p, l);
    return;
  }
  it -= 64;
  if (it < 64) {
    int b = it >> 5, h = (it >> 3) & 3, qt = it & 7;
    int row = NP + b * 1024 + qt * 128 + w * 16 + fr;
    bf16x8 qf[3];
#pragma unroll
    for (int ks = 0; ks < 3; ++ks) qf[ks] = ld16(M.qkv + (long)row * INP + C_QC + h * 96 + ks * 32 + fq * 8);
    AttnSt<2> st; attn_init<2>(st);
    const int bl = b * 4 + l;
    const u16* ck = M.cKnope + (long)bl * 512 * 256 + h * 64; const u16* cp = M.cKpe + (long)bl * 512 * 32; const u16* cv = M.cVtC + (long)(bl * 4 + h) * 64 * 512;
    const u16* nk = M.knope + (long)(NP + b * 1024) * 256 + h * 64; const u16* np_ = M.qkv + (long)(NP + b * 1024) * INP + C_KPE; const u16* nv = vtC + (long)NP * 256 + (long)((b * 4 + h) * 64) * 1024;
    auto src = [&](int i) { TileSrc s; if (i < 8) { s.K = ck + (long)i * 64 * 256; s.ldk = 256; s.Pe = cp + (long)i * 64 * 32; s.ldpe = 32; s.Vt = cv + i * 64; s.ldv = 512; } else { int j = i - 8; s.K = nk + (long)j * 64 * 256; s.ldk = 256; s.Pe = np_ + (long)j * 64 * INP; s.ldpe = INP; s.Vt = nv + j * 64; s.ldv = 1024; } return s; };
    attn_run<2>(lds, st, qf, 24, src, 0.10206207261596577f * L2E, tid, 1000, 0, 0, p.na_rpb, 0, 0);
    fin_mla(st, M.obuf + (long)row * DM + 512 + h * 64, fq);
    return;
  }
  it -= 64;
  if (it < 64) {
    int b = it >> 5, h = (it >> 3) & 3, rp = it & 7;
    const int r = rp * 2 + (w >> 2);
    int row = NP + b * 1024 + r * 64 + (w & 3) * 16 + fr;
    bf16x8 qf[2]; qf[0] = ld16(M.qkv + (long)row * INP + C_QA + h * 64 + fq * 8); qf[1] = ld16(M.qkv + (long)row * INP + C_QA + h * 64 + 32 + fq * 8);
    AttnSt<0> st; attn_init<0>(st);
    const int bl = (b * 4 + l) * 4 + h;
    const int r0a = min(max(rp * 2 - 4, 0), 8), r0b = min(max(rp * 2 + 1 - 4, 0), 8), r0w = min(max(r - 4, 0), 8);
    const int nrows = r0b + 8 - r0a;
    const u16* ck = M.cKa + (long)bl * 512 * 64; const u16* cv = M.cVtA + (long)bl * 64 * 512;
    const u16* nk = M.qkv + (long)(NP + b * 1024 + r0a * 64) * INP + C_KA + h * 64; const u16* nv = vtA + (long)NP * 256 + (long)((b * 4 + h) * 64) * 1024 + r0a * 64;
    auto src = [&](int i) { TileSrc s; if (i < 8) { s.K = ck + (long)i * 64 * 64; s.ldk = 64; s.Vt = cv + i * 64; s.ldv = 512; } else { int j = i - 8; s.K = nk + (long)j * 64 * INP; s.ldk = INP; s.Vt = nv + j * 64; s.ldv = 1024; } s.Pe = nullptr; s.ldpe = 0; return s; };
    attn_run<0>(lds, st, qf, 8 + nrows, src, 0.125f * L2E, tid, 8, 8 + (r0w - r0a), 16 + (r0w - r0a), p.na_rpb + (long)((l * 4 + h) * 15) * 31, r0a - 8 - r + 7, (w & 3) * 16);
    fin_std(st, M.obuf + (long)row * DM + 0 + h * 64, fq);
    return;
  }
  it -= 64;
  if (it < 384) {
    int kind = it >> 7; int i2 = it & 127;
    int b = i2 >> 3, h = (i2 >> 1) & 3, qt = i2 & 1;
    int row = b * 256 + qt * 128 + w * 16 + fr;
    if (kind == 0) {
      bf16x8 qf[2]; qf[0] = ld16(M.qkv + (long)row * INP + C_QB + h * 64 + fq * 8); qf[1] = ld16(M.qkv + (long)row * INP + C_QB + h * 64 + 32 + fq * 8);
      AttnSt<1> st; attn_init<1>(st);
      const u16* nk = M.qkv + (long)(b * 256) * INP + C_KB + h * 64; const u16* nv = vtB + (long)((b * 4 + h) * 64) * 256;
      auto src = [&](int i) { TileSrc s; s.K = nk + (long)i * 64 * INP; s.ldk = INP; s.Vt = nv + i * 64; s.ldv = 256; s.Pe = nullptr; s.ldpe = 0; return s; };
      attn_run<1>(lds, st, qf, 4, src, 0.17677669529663687f * L2E, tid, 1000, 0, 0, p.na_rpb, 0, 0);
      fin_diff(st, M.obuf + (long)row * DM + 256 + h * 64, fq, lane, p, l);
    } else if (kind == 1) {
      bf16x8 qf[3];
#pragma unroll
      for (int ks = 0; ks < 3; ++ks) qf[ks] = ld16(M.qkv + (long)row * INP + C_QC + h * 96 + ks * 32 + fq * 8);
      AttnSt<2> st; attn_init<2>(st);
      const u16* nk = M.knope + (long)(b * 256) * 256 + h * 64; const u16* np_ = M.qkv + (long)(b * 256) * INP + C_KPE; const u16* nv = vtC + (long)((b * 4 + h) * 64) * 256;
      auto src = [&](int i) { TileSrc s; s.K = nk + (long)i * 64 * 256; s.ldk = 256; s.Pe = np_ + (long)i * 64 * INP; s.ldpe = INP; s.Vt = nv + i * 64; s.ldv = 256; return s; };
      attn_run<2>(lds, st, qf, 4, src, 0.10206207261596577f * L2E, tid, 1000, 0, 0, p.na_rpb, 0, 0);
      fin_mla(st, M.obuf + (long)row * DM + 512 + h * 64, fq);
    } else {
      bf16x8 qf[2]; qf[0] = ld16(M.qkv + (long)row * INP + C_QA + h * 64 + fq * 8); qf[1] = ld16(M.qkv + (long)row * INP + C_QA + h * 64 + 32 + fq * 8);
      AttnSt<0> st; attn_init<0>(st);
      const u16* nk = M.qkv + (long)(b * 256) * INP + C_KA + h * 64; const u16* nv = vtA + (long)((b * 4 + h) * 64) * 256;
      auto src = [&](int i) { TileSrc s; s.K = nk + (long)i * 64 * INP; s.ldk = INP; s.Vt = nv + i * 64; s.ldv = 256; s.Pe = nullptr; s.ldpe = 0; return s; };
      attn_run<0>(lds, st, qf, 4, src, 0.125f * L2E, tid, 1000, 0, 0, p.na_rpb, 0, 0);
      fin_std(st, M.obuf + (long)row * DM + 0 + h * 64, fq);
    }
    return;
  }
  it -= 384;
  {
    int wi = it * 8 + w;
    int chunk = wi >> 5, g = (wi >> 3) & 3, pt = wi & 7;
    f32x4 D[4];
#pragma unroll
    for (int ct = 0; ct < 4; ++ct) D[ct] = f32x4{0.f, 0.f, 0.f, 0.f};
    const u16* wrow = M.sguW + ((long)((l * 4 + g) * 128 + pt * 16 + fr)) * 128 + fq * 8;
#pragma unroll
    for (int ks = 0; ks < 4; ++ks) {
      bf16x8 bw = ld16(wrow + ks * 32);
#pragma unroll
      for (int ct = 0; ct < 4; ++ct) {
        bf16x8 av = ld16(M.vgt + ((long)((chunk * 4 + g) * 64 + ct * 16 + fr)) * 128 + ks * 32 + fq * 8);
        D[ct] = __builtin_amdgcn_mfma_f32_16x16x32_bf16(av, bw, D[ct], 0, 0, 0);
      }
    }
    int row = chunk * 128 + pt * 16 + fr;
    float bias = p.sgu_b[(l * 4 + g) * 128 + pt * 16 + fr];
#pragma unroll
    for (int ct = 0; ct < 4; ++ct) {
      uint2 uu = *reinterpret_cast<const uint2*>(M.qkv + (long)row * INP + C_U + g * 64 + ct * 16 + 4 * fq);
      st_pk4(M.obuf + (long)row * DM + 768 + g * 64 + ct * 16 + 4 * fq, bflo(uu.x) * (D[ct][0] + bias), bfhi(uu.x) * (D[ct][1] + bias),
             bflo(uu.y) * (D[ct][2] + bias), bfhi(uu.y) * (D[ct][3] + bias));
    }
  }
}

DEV void mixer_phase(char* lds, const MixCtx& M, unsigned* counter, int tid) {
  volatile int* qslot = (volatile int*)(lds + LQSLOT);
  for (;;) {
    if (tid == 0) *qslot = (int)atomicAdd(counter, 1u);
    __syncthreads();
    const int it = __builtin_amdgcn_readfirstlane(*qslot);
    __syncthreads();
    if (it >= MIX_BLOCK_ITEMS) break;
    { int t2 = tid; asm volatile("" : "+v"(t2)); mixer_block_item(lds, M, it, t2); }
  }
}

#define XB_TMO      128
#define XB_XCNT(j)  (256  + 64 * (j))
#define XB_XSUB(j)  (1280 + 64 * (j))
#define XB_XGEN(j)  (2304 + 64 * (j))
#define XB_TOP      3328
#define XB_TOPGEN   3392
#define XCD_BAR_WORDS 3456
#define XB_SPIN_CAP (1u << 18)
#define LAS __attribute__((address_space(3)))

__device__ __forceinline__ unsigned xb_ld(unsigned* p)              { return __hip_atomic_load(p, __ATOMIC_RELAXED, __HIP_MEMORY_SCOPE_AGENT); }
__device__ __forceinline__ unsigned xb_add(unsigned* p, unsigned v) { return __hip_atomic_fetch_add(p, v, __ATOMIC_RELAXED, __HIP_MEMORY_SCOPE_AGENT); }
__device__ __forceinline__ unsigned xb_xcc_id() { return (unsigned)__builtin_amdgcn_s_getreg((3 << 11) | 20) & 0xFu; }
#define XB_SPIN(cond, bar) do { unsigned _sp = 0; while (cond) { __builtin_amdgcn_s_sleep(1); \
    if ((++_sp & 255u) == 0u) { if (xb_ld(&(bar)[XB_TMO])) break; if (_sp > XB_SPIN_CAP) { atomicAdd(&(bar)[XB_TMO], 1u); break; } } } } while (0)

struct XcdBarrier {
    unsigned* bar; unsigned x;
    volatile LAS unsigned* st;
};

__device__ __forceinline__ XcdBarrier xcd_barrier_post(unsigned* bar, volatile LAS unsigned* st) {
    XcdBarrier b; b.bar = bar; b.x = xb_xcc_id(); b.st = st;
    if (threadIdx.x == 0) (void)xb_add(&bar[XB_XCNT(b.x)], 1u);
    return b;
}
__device__ __forceinline__ void xcd_barrier_complete(unsigned* bar, unsigned x, unsigned& nloc, unsigned& nx) {
    const unsigned G = gridDim.x * gridDim.y * gridDim.z;
    unsigned sum, cnt, mine, sp = 0u;
    for (;;) {
        sum = 0u; cnt = 0u; mine = 0u;
#pragma unroll
        for (unsigned j = 0; j < 16; ++j) { const unsigned c = xb_ld(&bar[XB_XCNT(j)]); sum += c; cnt += (c > 0u) ? 1u : 0u; mine = (j == x) ? c : mine; }
        if (sum == G) break;
        __builtin_amdgcn_s_sleep(1);
        if ((++sp & 255u) == 0u) { if (xb_ld(&bar[XB_TMO])) break; if (sp > XB_SPIN_CAP) { atomicAdd(&bar[XB_TMO], 1u); break; } }
    }
    nloc = mine > 0u ? mine : 1u; nx = cnt > 0u ? cnt : 1u;
}

__device__ __forceinline__ void xcd_barrier(const XcdBarrier& b) {
    asm volatile("s_waitcnt vmcnt(0)" ::: "memory");
    __syncthreads();
    if (threadIdx.x == 0) {
        unsigned* bar = b.bar;
        __builtin_amdgcn_s_waitcnt(0);
        unsigned nloc = b.st[0], nx = b.st[1];
        if (nloc == 0u) { xcd_barrier_complete(bar, b.x, nloc, nx); b.st[0] = nloc; b.st[1] = nx; }
        const unsigned old = xb_add(&bar[XB_XSUB(b.x)], 1u);
        const unsigned gen = old / nloc;
        if (old + 1u == (gen + 1u) * nloc) {
            __builtin_amdgcn_fence(__ATOMIC_RELEASE, "agent");
            asm volatile("s_waitcnt vmcnt(0)" ::: "memory");
            const unsigned og = xb_add(&bar[XB_TOP], 1u);
            const unsigned tg = og / nx;
            if (og + 1u == (tg + 1u) * nx) xb_add(&bar[XB_TOPGEN], 1u);
            else XB_SPIN(xb_ld(&bar[XB_TOPGEN]) == tg, bar);
            __builtin_amdgcn_fence(__ATOMIC_ACQUIRE, "agent");
            xb_add(&bar[XB_XGEN(b.x)], 1u);
            asm volatile("s_waitcnt vmcnt(0)" ::: "memory");
        } else {
            XB_SPIN(xb_ld(&bar[XB_XGEN(b.x)]) == gen, bar);
            __builtin_amdgcn_fence(__ATOMIC_ACQUIRE, "agent");
            asm volatile("s_waitcnt vmcnt(0)" ::: "memory");
        }
    }
    __syncthreads();
}


DEV void ada_item(float* sl, const Params& p, float* adap, int idx) {
  int l = idx / 48, rem = idx % 48, ks = rem / 3, cgi = rem % 3;
  int tid = threadIdx.x;
  if (tid < 192) { int r = tid >> 6, k = ks * 64 + (tid & 63); float m = (r == 0) ? p.c_ctx[k] : p.c[(r - 1) * 1024 + k]; sl[tid] = m / (1.f + expf(-m)); }
  __syncthreads();
  int n = cgi * 2048 + tid * 4;
  float4 a0 = {0, 0, 0, 0}, a1 = {0, 0, 0, 0}, a2 = {0, 0, 0, 0};
  const float* w = p.w_ada + ((long)l * 1024 + ks * 64) * 6144 + n;
#pragma unroll 8
  for (int k = 0; k < 64; ++k) {
    float4 v = NT_LD4(w + (long)k * 6144);
    float s0 = sl[k], s1 = sl[64 + k], s2 = sl[128 + k];
    a0.x += s0 * v.x; a0.y += s0 * v.y; a0.z += s0 * v.z; a0.w += s0 * v.w;
    a1.x += s1 * v.x; a1.y += s1 * v.y; a1.z += s1 * v.z; a1.w += s1 * v.w;
    a2.x += s2 * v.x; a2.y += s2 * v.y; a2.z += s2 * v.z; a2.w += s2 * v.w;
  }
  float* o = adap + ((long)(l * 16 + ks) * 3) * 6144 + n;
  *reinterpret_cast<float4*>(o) = a0; *reinterpret_cast<float4*>(o + 6144) = a1; *reinterpret_cast<float4*>(o + 2 * 6144) = a2;
  __syncthreads();
}

struct TrDesc { const float* src; u16* dst; const float* kscale; int ldN, k0, n0, mapmode, ldd, nw; };
DEV void tr_load(float4 (&r)[4], const TrDesc& d, int tid) {
#pragma unroll
  for (int i = 0; i < 4; ++i) {
    int idx = tid + i * 512; int kr = idx >> 5, c4 = (idx & 31) * 4;
    int nd = d.n0 + c4, ns = nd; bool pad = (c4 >= d.nw);
    if (d.mapmode == 1) { if (nd >= C_U) ns = nd - 96; else if (nd >= 2080) pad = true; }
    float4 v = {0.f, 0.f, 0.f, 0.f};
    if (!pad) v = NT_LD4(d.src + (long)(d.k0 + kr) * d.ldN + ns);
    if (d.kscale) { float sc = d.kscale[d.k0 + kr]; v.x *= sc; v.y *= sc; v.z *= sc; v.w *= sc; }
    r[i] = v;
  }
}
DEV void tr_store(float* tl, const float4 (&r)[4], const TrDesc& d, int tid) {
#pragma unroll
  for (int i = 0; i < 4; ++i) {
    int idx = tid + i * 512; int kr = idx >> 5, c4 = (idx & 31) * 4;
    float* t = tl + kr * 129 + c4; t[0] = r[i].x; t[1] = r[i].y; t[2] = r[i].z; t[3] = r[i].w;
  }
  __syncthreads();
  int n = tid >> 2, kc = (tid & 3) * 16;
  if (n < d.nw) {
    unsigned w[8];
#pragma unroll
    for (int i = 0; i < 8; ++i) w[i] = pk2(tl[(kc + 2 * i) * 129 + n], tl[(kc + 2 * i + 1) * 129 + n]);
    uint4* o = reinterpret_cast<uint4*>(d.dst + (long)(d.n0 + n) * d.ldd + d.k0 + kc);
    o[0] = uint4{w[0], w[1], w[2], w[3]}; o[1] = uint4{w[4], w[5], w[6], w[7]};
  }
  __syncthreads();
}

constexpr int T_ADA = 192, T_WIN = 4 * 16 * 21, T_WOUT = 4 * 16 * 8, T_FF1 = 4 * 16 * 32, T_FF2 = 4 * 64 * 8, T_UKV = 64, T_CV = 512;
constexpr int T_TOTAL = T_ADA + T_WIN + T_WOUT + T_FF1 + T_FF2 + T_UKV + T_CV;

DEV void cvt_stream(const float* src, u16* dst, long n, long gtid, long gthreads) {
  for (long i = gtid; i < n / 4; i += gthreads) {
    float4 v = NT_LD4(reinterpret_cast<const float4*>(src) + i);
    uint2 o; o.x = pk2(v.x, v.y); o.y = pk2(v.z, v.w);
    reinterpret_cast<uint2*>(dst)[i] = o;
  }
}

__global__ void __launch_bounds__(512, 2) fwd_megakernel(Params p, int ph_lo, int ph_hi) {
  __shared__ __attribute__((aligned(16))) char lds[LDS_BYTES];
  cg::grid_group grid = cg::this_grid();
  const int wv = __builtin_amdgcn_readfirstlane((int)threadIdx.x >> 6);
  const int tid = opaque_tid(wv), wid = tid >> 6, lane = tid & 63;
  const long gtid = (long)blockIdx.x * NTHR + tid, gthreads = (long)gridDim.x * NTHR;
  const int gwave = blockIdx.x * 8 + wid, gwaves = gridDim.x * 8;
  char* ws = p.ws;
  u16* Wt_in = (u16*)(ws + W_WIN); u16* Wt_out = (u16*)(ws + W_WOUT); u16* Wt_ff1 = (u16*)(ws + W_WFF1); u16* Wt_ff2 = (u16*)(ws + W_WFF2);
  u16* Wt_ukvr = (u16*)(ws + W_UKVR); u16* Wt_ukvg = (u16*)(ws + W_UKVG); u16* sguW = (u16*)(ws + W_SGUW);
  float* xbuf = (float*)(ws + W_X); u16* xa = (u16*)(ws + W_XA); float* ssp = (float*)(ws + W_SS);
  u16* qkv = (u16*)(ws + W_QKV); u16* obuf = (u16*)(ws + W_O); u16* hid = (u16*)(ws + W_HID); u16* knope = (u16*)(ws + W_KNOPE);
  u16* vt = (u16*)(ws + W_VT); u16* vgt = (u16*)(ws + W_VGT);
  u16* cKa = (u16*)(ws + W_CKA); u16* cVtA = (u16*)(ws + W_CVTA); u16* cKb = (u16*)(ws + W_CKB); u16* cVtB = (u16*)(ws + W_CVTB);
  u16* cKpe = (u16*)(ws + W_CKPE); u16* cCkv = (u16*)(ws + W_CCKV); u16* cKnope = (u16*)(ws + W_CKNOPE); u16* cVtC = (u16*)(ws + W_CVTC);
  float* adap = (float*)(ws + W_ADAP); float* E = (float*)(ws + W_E); float* shin = (float*)(ws + W_SHIN); float* shff = (float*)(ws + W_SHFF);
  float2* rope = (float2*)(ws + W_ROPE);

  if (tid < 4) ((volatile unsigned*)(lds + LBARW))[tid] = 0u;
  __syncthreads();
  XcdBarrier xbar = xcd_barrier_post((unsigned*)(ws + W_BAR), (volatile LAS unsigned*)(lds + LBARW));
  if (ph_hi < 0) grid.sync();
  int ph = 0;
#ifndef REPMASK
#define REPMASK 0
#endif
#define NREP(id) ((((REPMASK) >> (id)) & 1) ? 2 : 1)
#define PHASE_BEGIN(id) if (ph >= ph_lo && ph < ph_hi) { for (int rep = 0; rep < NREP(id); ++rep) { if (rep) xcd_barrier(xbar); const int dry = (rep + 1 < NREP(id)) ? 1 : 0; (void)dry;
#define PHASE_END } } ++ph; if (ph > ph_lo && ph < ph_hi) xcd_barrier(xbar);

  PHASE_BEGIN(0)
  for (int it = blockIdx.x; it < T_ADA; it += gridDim.x) ada_item((float*)lds, p, adap, it);
  {
    auto decode = [&](int i, TrDesc& d) {
      d.kscale = nullptr; d.mapmode = 0; d.nw = 128;
      if (i < T_WIN) { int l = i / 336, rem = i % 336, kt = rem / 21, ntl = rem % 21; d.src = p.w_in + (long)l * DM * INC; d.ldN = INC; d.k0 = kt * 64; d.n0 = ntl * 128; d.mapmode = 1; d.dst = Wt_in + (long)l * INP * DM; d.ldd = DM; return; }
      i -= T_WIN;
      if (i < T_WOUT) { int l = i >> 7, rem = i & 127, kt = rem >> 3, ntl = rem & 7; d.src = p.w_out + (long)l * DM * DM; d.ldN = DM; d.k0 = kt * 64; d.n0 = ntl * 128; d.dst = Wt_out + (long)l * DM * DM; d.ldd = DM; return; }
      i -= T_WOUT;
      if (i < T_FF1) { int l = i >> 9, rem = i & 511, kt = rem >> 5, ntl = rem & 31; d.src = p.w_ff1 + (long)l * DM * FF; d.ldN = FF; d.k0 = kt * 64; d.n0 = ntl * 128; d.dst = Wt_ff1 + (long)l * FF * DM; d.ldd = DM; return; }
      i -= T_FF1;
      if (i < T_FF2) { int l = i >> 9, rem = i & 511, kt = rem >> 3, ntl = rem & 7; d.src = p.w_ff2 + (long)l * FF * DM; d.ldN = DM; d.k0 = kt * 64; d.n0 = ntl * 128; d.dst = Wt_ff2 + (long)l * DM * FF; d.ldd = FF; return; }
      i -= T_FF2;
      if (i < T_UKV) {
        int l = i >> 4, which = (i >> 3) & 1, fold = (i >> 2) & 1, kt = (i >> 1) & 1, ntl = i & 1;
        d.src = (which ? p.w_uv : p.w_uk) + (long)l * 128 * 256; d.ldN = 256; d.k0 = kt * 64; d.n0 = ntl * 128;
        d.dst = (fold ? Wt_ukvg : Wt_ukvr) + (long)l * 512 * 128 + (long)which * 256 * 128; d.ldd = 128; d.kscale = fold ? (p.g_ckv + l * 128) : nullptr; return;
      }
      i -= T_UKV;
      { int which = i >> 8, mat = (i >> 3) & 31, kt = i & 7;
        d.src = (which ? p.c_diff_v : p.c_na_v) + (long)mat * 512 * 64; d.ldN = 64; d.k0 = kt * 64; d.n0 = 0; d.nw = 64;
        d.dst = (which ? cVtB : cVtA) + (long)mat * 64 * 512; d.ldd = 512; }
    };
    constexpr int NTR = T_TOTAL - T_ADA;
    int i = blockIdx.x;
    if (i < NTR) {
      TrDesc cur, nxt; float4 rc[4], rn[4];
      decode(i, cur); tr_load(rc, cur, tid);
      for (; i < NTR; i += gridDim.x) {
        const int inext = i + gridDim.x; const bool more = inext < NTR;
        if (more) { decode(inext, nxt); tr_load(rn, nxt, tid); }
        tr_store((float*)lds, rc, cur, tid);
        if (more) { cur = nxt;
#pragma unroll
          for (int q = 0; q < 4; ++q) rc[q] = rn[q]; }
      }
    }
  }
  cvt_stream(p.c_na_k, cKa, 1048576, gtid, gthreads);
  cvt_stream(p.c_diff_k, cKb, 1048576, gtid, gthreads);
  cvt_stream(p.c_mla_kpe, cKpe, 131072, gtid, gthreads);
  cvt_stream(p.c_mla_ckv, cCkv, 524288, gtid, gthreads);
  cvt_stream(p.sgu_w, sguW, 262144, gtid, gthreads);
  if (gtid < 512) {
    int pos = (int)gtid >> 3, i = (int)gtid & 7;
    float freq = powf(10000.f, -(float)i / 8.f); float ang = (float)pos * freq;
    rope[gtid] = make_float2(cosf(ang), sinf(ang));
  }
  PHASE_END

  PHASE_BEGIN(1)
  for (long i = gtid; i < (long)NL * 3 * 6144; i += gthreads) {
    int l = (int)(i / 18432), rem = (int)(i % 18432), r = rem / 6144, n = rem % 6144;
    float a = p.b_ada[l * 6144 + n];
#pragma unroll
    for (int ks = 0; ks < 16; ++ks) a += adap[((long)(l * 16 + ks) * 3 + r) * 6144 + n];
    E[i] = a;
  }
  PHASE_END

  PHASE_BEGIN(2)
  {
    ProbCache pc{cCkv, Wt_ukvr, 128, 128, 128};
    EpiUKV ec{1, 0, nullptr, nullptr, nullptr, cKnope, cVtC};
    gemm_phase<4, 4, 3>(lds, pc, ec, wv);
  }
  for (int it4 = gwave * 4; it4 < NL * (INP + FF); it4 += gwaves * 4) {
    int l, n; const u16* wrow; const float* sh; float* dst; int ldd;
    if (it4 < NL * INP) { l = it4 / INP; n = it4 % INP; wrow = Wt_in + ((long)l * INP + n) * DM; sh = E + (long)l * 18432 + 0; dst = shin + (long)l * 3 * INP + n; ldd = INP; }
    else { int j = it4 - NL * INP; l = j / FF; n = j % FF; wrow = Wt_ff1 + ((long)l * FF + n) * DM; sh = E + (long)l * 18432 + 3072; dst = shff + (long)l * 3 * FF + n; ldd = FF; }
    bf16x8 wq[4][2];
#pragma unroll
    for (int c = 0; c < 4; ++c)
#pragma unroll
      for (int hlf = 0; hlf < 2; ++hlf) wq[c][hlf] = ld16(wrow + (long)c * DM + hlf * 512 + lane * 8);
    float acc3[4][3];
#pragma unroll
    for (int c = 0; c < 4; ++c) { acc3[c][0] = 0.f; acc3[c][1] = 0.f; acc3[c][2] = 0.f; }
#pragma unroll
    for (int hlf = 0; hlf < 2; ++hlf) {
      const int k = hlf * 512 + lane * 8;
      float s0[8], s1[8], s2[8];
#pragma unroll
      for (int e = 0; e < 8; ++e) { s0[e] = sh[k + e]; s1[e] = sh[6144 + k + e]; s2[e] = sh[2 * 6144 + k + e]; }
#pragma unroll
      for (int c = 0; c < 4; ++c)
#pragma unroll
        for (int e = 0; e < 8; ++e) { float wf = bf2f((u16)wq[c][hlf][e]); acc3[c][0] += wf * s0[e]; acc3[c][1] += wf * s1[e]; acc3[c][2] += wf * s2[e]; }
    }
#pragma unroll
    for (int c = 0; c < 4; ++c) {
      float a0 = wave_sum(acc3[c][0]), a1 = wave_sum(acc3[c][1]), a2 = wave_sum(acc3[c][2]);
      if (lane == 0) { dst[c] = a0; dst[ldd + c] = a1; dst[2 * ldd + c] = a2; }
    }
  }
  for (int row = gwave; row < NT; row += gwaves) {
    const float* src = (row < NP) ? (p.x_prompt + (long)row * DM) : (p.x_sample + (long)(row - NP) * DM);
    int ridx = (row < NP) ? 0 : 1 + ((row - NP) >> 10);
    const float* sc1 = E + ridx * 6144 + 1024;
    float sq = 0.f;
    float4 vq[4], gq[4], sq4[4];
#pragma unroll
    for (int i = 0; i < 4; ++i) { int k = i * 256 + lane * 4; vq[i] = NT_LD4(src + k); gq[i] = *reinterpret_cast<const float4*>(p.g_mix + k); sq4[i] = *reinterpret_cast<const float4*>(sc1 + k); }
#pragma unroll
    for (int i = 0; i < 4; ++i) {
      int k = i * 256 + lane * 4;
      float4 v = vq[i], g = gq[i], s = sq4[i];
      *reinterpret_cast<float4*>(xbuf + (long)row * DM + k) = v;
      sq += v.x * v.x + v.y * v.y + v.z * v.z + v.w * v.w;
      st_pk4(xa + (long)row * DM + k, v.x * g.x * (1.f + s.x), v.y * g.y * (1.f + s.y), v.z * g.z * (1.f + s.z), v.w * g.w * (1.f + s.w));
    }
    sq = wave_sum(sq);
    if (lane < 16) ssp[(long)row * 16 + lane] = (lane == 0) ? sq : 0.f;
  }
  PHASE_END

#pragma unroll 1
  for (int l = 0; l < NL; ++l) {
    const float* El = E + (long)l * 18432;
    PHASE_BEGIN(3)
    { ProbStd pb{xa, Wt_in + (long)l * INP * DM, DM, DM, DM, 24, 21, 256, 128};
      EpiIn ep{ssp, shin + (long)l * 3 * INP, qkv, vt, vgt, rope, p.sgu_g + l * 256, p.out, l};
      gemm_phase<4, 4, 3>(lds, pb, ep, wv); }
    PHASE_END
    PHASE_BEGIN(4)
    { ProbStd pb{qkv + C_CKV, Wt_ukvg + (long)l * 512 * 128, INP, 128, 128, 24, 4, 256, 128};
      EpiUKV ep{0, l, qkv, p.g_ckv + l * 128, p.out, knope, vt + (long)2 * NT * 256};
      gemm_phase<4, 4, 3>(lds, pb, ep, wv); }
    PHASE_END
    PHASE_BEGIN(5)
    { MixCtx M{&p, l, qkv, knope, vt, vgt, obuf, cKa, cVtA, cKb, cVtB, cKpe, cKnope, cVtC, sguW};
      mixer_phase(lds, M, (unsigned*)(ws + W_CNT) + l * 64 + rep * 16, opaque_tid(wv)); }
    PHASE_END
    PHASE_BEGIN(6)
    { ProbStd pb{obuf, Wt_out + (long)l * DM * DM, DM, DM, DM, 32, 8, 192, 128};
      EpiRes ep{xbuf, xa, ssp, El + 2048, p.g_ffn + l * DM, El + 4096, dry};
      gemm_phase<3, 4, 3>(lds, pb, ep, wv); }
    PHASE_END
    PHASE_BEGIN(7)
    { ProbStd pb{xa, Wt_ff1 + (long)l * FF * DM, DM, DM, DM, 32, 16, 192, 256};
      EpiFF1 ep{ssp, shff + (long)l * 3 * FF, hid};
      gemm_phase<3, 8, 2>(lds, pb, ep, wv); }
    PHASE_END
    PHASE_BEGIN(8)
    { ProbStd pb{hid, Wt_ff2 + (long)l * DM * FF, FF, FF, FF, 32, 8, 192, 128};
      EpiRes ep{xbuf, xa, ssp, El + 5120, (l + 1 < NL) ? (p.g_mix + (l + 1) * DM) : nullptr, (l + 1 < NL) ? (E + (long)(l + 1) * 18432 + 1024) : nullptr, dry};
      gemm_phase<3, 4, 3>(lds, pb, ep, wv); }
    PHASE_END
  }

  PHASE_BEGIN(9)
  const int t9 = opaque_tid(wv); const int lane9 = t9 & 63;
  for (int row = blockIdx.x * 8 + (t9 >> 6); row < NT; row += gridDim.x * 8) {
    const int lane = lane9;
    float t = (lane < 16) ? ssp[(long)row * 16 + lane] : 0.f;
    t = wave_sum(t);
    float rs = rsqrtf(t * (1.f / 1024.f) + 1e-6f);
    float4 vq[4], gq[4];
#pragma unroll
    for (int i = 0; i < 4; ++i) { int k = i * 256 + lane * 4; vq[i] = NT_LD4(xbuf + (long)row * DM + k); gq[i] = *reinterpret_cast<const float4*>(p.g_final + k); }
#pragma unroll
    for (int i = 0; i < 4; ++i) {
      int k = i * 256 + lane * 4;
      float4 v = vq[i], g = gq[i];
      float4 o = {v.x * rs * g.x, v.y * rs * g.y, v.z * rs * g.z, v.w * rs * g.w};
      { typedef float f4v __attribute__((ext_vector_type(4))); f4v ov = {o.x, o.y, o.z, o.w}; __builtin_nontemporal_store(ov, reinterpret_cast<f4v*>(p.out + (long)row * DM + k)); }
    }
  }
  PHASE_END
}

extern "C" void kernel_launch(void* const* d_in, const int* in_sizes, int n_in, void* d_out, int out_size, void* d_ws, size_t ws_size, hipStream_t stream) {
  static int grid_blocks = 0;
  if (!grid_blocks) {
    int dev = 0, cus = 0, per_cu = 0;
    hipGetDevice(&dev);
    hipDeviceGetAttribute(&cus, hipDeviceAttributeMultiprocessorCount, dev);
    hipOccupancyMaxActiveBlocksPerMultiprocessor(&per_cu, fwd_megakernel, NTHR, 0);
    if (per_cu > 1) per_cu = 1;
    grid_blocks = cus * per_cu;
  }
  if (ws_size < W_END) { fprintf(stderr, "workspace too small: %zu < %zu\n", ws_size, (size_t)W_END); return; }
  Params p{};
  const float** f = (const float**)&p;
  for (int i = 0; i < 31; ++i) f[i] = (const float*)d_in[i];
  p.out = (float*)d_out; p.ws = (char*)d_ws;
  if (hipMemsetAsync((char*)d_ws + W_BAR, 0, W_END - W_BAR, stream) != hipSuccess) { fprintf(stderr, "memset failed\n"); return; }
  int lo = 0, hi = 1000;
  void* args[] = {&p, &lo, &hi};
  hipError_t e = hipLaunchCooperativeKernel((void*)fwd_megakernel, dim3(grid_blocks), dim3(NTHR), args, 0, stream);
  if (e != hipSuccess) fprintf(stderr, "cooperative launch failed: %s (grid %d)\n", hipGetErrorString(e), grid_blocks);
}
```

```cpp
#include <hip/hip_runtime.h>
#include <hip/hip_cooperative_groups.h>
#include <cstdio>
namespace cg = cooperative_groups;

typedef unsigned short u16;
typedef float f4v __attribute__((ext_vector_type(4)));
#define NT_LD4(p) ([&]{ f4v _t = __builtin_nontemporal_load(reinterpret_cast<const f4v*>(p)); return float4{_t.x, _t.y, _t.z, _t.w}; }())
using bf16x8 = __attribute__((ext_vector_type(8))) short;
using bf16x4 = __attribute__((ext_vector_type(4))) short;
using f32x4 = __attribute__((ext_vector_type(4))) float;
#define DEV __device__ __forceinline__

constexpr int DM = 1024, NP = 4096, NS = 2048, NT = 6144, NL = 4;
constexpr int INC = 2592, INP = 2688, FF = 4096;
constexpr int C_QA = 0, C_KA = 256, C_VA = 512, C_QB = 768, C_KB = 1024, C_VB = 1280, C_QC = 1536, C_CKV = 1920, C_KPE = 2048, C_U = 2176, C_VS = 2432;

constexpr long O_YP = 0, O_YS = 4194304, O_NAK = 6291456, O_NAV = 10485760, O_DK = 14680064, O_DV = 18874368, O_CKV = 23068672, O_KPE = 25165824;

constexpr size_t al256(size_t x) { return (x + 255) & ~(size_t)255; }
constexpr size_t W_WIN = 0;
constexpr size_t W_WOUT = W_WIN + al256((size_t)NL * INP * DM * 2);
constexpr size_t W_WFF1 = W_WOUT + al256((size_t)NL * DM * DM * 2);
constexpr size_t W_WFF2 = W_WFF1 + al256((size_t)NL * FF * DM * 2);
constexpr size_t W_UKVR = W_WFF2 + al256((size_t)NL * DM * FF * 2);
constexpr size_t W_UKVG = W_UKVR + al256((size_t)NL * 512 * 128 * 2);
constexpr size_t W_SGUW = W_UKVG + al256((size_t)NL * 512 * 128 * 2);
constexpr size_t W_X = W_SGUW + al256((size_t)NL * 4 * 128 * 128 * 2);
constexpr size_t W_XA = W_X + al256((size_t)NT * DM * 4);
constexpr size_t W_SS = W_XA + al256((size_t)NT * DM * 2);
constexpr size_t W_QKV = W_SS + al256((size_t)NT * 16 * 4);
constexpr size_t W_O = W_QKV + al256((size_t)NT * INP * 2);
constexpr size_t W_HID = W_O + al256((size_t)NT * DM * 2);
constexpr size_t W_KNOPE = W_HID + al256((size_t)NT * FF * 2);
constexpr size_t W_VT = W_KNOPE + al256((size_t)NT * 256 * 2);
constexpr size_t W_VGT = W_VT + al256((size_t)3 * NT * 256 * 2);
constexpr size_t W_CKA = W_VGT + al256((size_t)NT * 256 * 2);
constexpr size_t W_CVTA = W_CKA + al256((size_t)1048576 * 2);
constexpr size_t W_CKB = W_CVTA + al256((size_t)1048576 * 2);
constexpr size_t W_CVTB = W_CKB + al256((size_t)1048576 * 2);
constexpr size_t W_CKPE = W_CVTB + al256((size_t)1048576 * 2);
constexpr size_t W_CCKV = W_CKPE + al256((size_t)131072 * 2);
constexpr size_t W_CKNOPE = W_CCKV + al256((size_t)524288 * 2);
constexpr size_t W_CVTC = W_CKNOPE + al256((size_t)1048576 * 2);
constexpr size_t W_ADAP = W_CVTC + al256((size_t)1048576 * 2);
constexpr size_t W_E = W_ADAP + al256((size_t)NL * 16 * 3 * 6144 * 4);
constexpr size_t W_SHIN = W_E + al256((size_t)NL * 3 * 6144 * 4);
constexpr size_t W_SHFF = W_SHIN + al256((size_t)NL * 3 * INP * 4);
constexpr size_t W_ROPE = W_SHFF + al256((size_t)NL * 3 * FF * 4);
constexpr size_t W_BAR = W_ROPE + al256(64 * 8 * 8);
constexpr size_t W_CNT = W_BAR + al256(3456 * 4);
constexpr size_t W_END = W_CNT + 1024;

struct Params {
  const float *x_prompt, *x_sample, *c_na_k, *c_na_v, *c_diff_k, *c_diff_v, *c_mla_ckv, *c_mla_kpe, *c, *c_ctx;
  const float *w_ada, *b_ada, *g_mix, *g_ffn, *w_in, *w_out, *na_rpb, *lq1, *lk1, *lq2, *lk2, *g_subln, *g_ckv, *w_uk, *w_uv;
  const float *sgu_g, *sgu_w, *sgu_b, *w_ff1, *w_ff2, *g_final;
  float* out;
  char* ws;
};

DEV u16 f2bf(float f) { unsigned u = __builtin_bit_cast(unsigned, f); return (u16)((u + 0x7fffu + ((u >> 16) & 1u)) >> 16); }
typedef __bf16 bf16x2_t __attribute__((ext_vector_type(2)));
typedef float f32x2_t __attribute__((ext_vector_type(2)));
DEV unsigned pk2(float lo, float hi) { f32x2_t v = {lo, hi}; bf16x2_t b = __builtin_convertvector(v, bf16x2_t); return __builtin_bit_cast(unsigned, b); }
DEV float bf2f(u16 h) { return __builtin_bit_cast(float, (unsigned)h << 16); }
DEV float bflo(unsigned w) { return __builtin_bit_cast(float, w << 16); }
DEV float bfhi(unsigned w) { return __builtin_bit_cast(float, w & 0xffff0000u); }
DEV float gelu_t(float x) { float u = 0.7978845608028654f * (x + 0.044715f * x * x * x); float e = __expf(2.f * u); float t = 1.f - 2.f / (e + 1.f); return 0.5f * x * (1.f + t); }
DEV float ex2(float x) { return __builtin_amdgcn_exp2f(x); }
DEV bf16x8 ld16(const u16* p) { return *reinterpret_cast<const bf16x8*>(p); }
DEV bf16x4 ld8(const u16* p) { return *reinterpret_cast<const bf16x4*>(p); }
DEV void st_pk4(u16* p, float a, float b, float c, float d) { uint2 v; v.x = pk2(a, b); v.y = pk2(c, d); *reinterpret_cast<uint2*>(p) = v; }
DEV int opaque_tid(int wv) { int t = (wv << 6) | (int)__builtin_amdgcn_mbcnt_hi(~0u, __builtin_amdgcn_mbcnt_lo(~0u, 0u)); asm volatile("" : "+v"(t)); return t; }
DEV int ridx_of_mt(int mt) { return mt < 16 ? 0 : 1 + ((mt - 16) >> 2); }
DEV float xrow16_max(float x) {
  auto s = __builtin_amdgcn_permlane16_swap(__float_as_uint(x), __float_as_uint(x), false, false);
  x = fmaxf(__uint_as_float(s[0]), __uint_as_float(s[1]));
  auto t = __builtin_amdgcn_permlane32_swap(__float_as_uint(x), __float_as_uint(x), false, false);
  return fmaxf(__uint_as_float(t[0]), __uint_as_float(t[1]));
}
DEV float xrow16_sum(float x) {
  auto s = __builtin_amdgcn_permlane16_swap(__float_as_uint(x), __float_as_uint(x), false, false);
  x = __uint_as_float(s[0]) + __uint_as_float(s[1]);
  auto t = __builtin_amdgcn_permlane32_swap(__float_as_uint(x), __float_as_uint(x), false, false);
  return __uint_as_float(t[0]) + __uint_as_float(t[1]);
}
DEV float red16(float v) { v += __shfl_xor(v, 1); v += __shfl_xor(v, 2); v += __shfl_xor(v, 4); v += __shfl_xor(v, 8); return v; }
DEV float wave_sum(float v) { v = red16(v); v += __shfl_xor(v, 16); v += __shfl_xor(v, 32); return v; }

constexpr int NTHR = 512;
constexpr int GSTG = 49152, GBO = 32768, LSCR = 3 * 49152, LBARW = LSCR + 1024, LQSLOT = LBARW + 32, LDS_BYTES = LBARW + 64;
DEV void stage_rc(int b, int& R, int& C) { int st = b / 1024, sb = b % 1024, swz = sb ^ (((sb >> 9) & 1) << 5); R = (st >> 1) * 16 + swz / 64; C = (st & 1) * 32 + (swz % 64) / 2; }

template <int NI>
DEV void stage_tile(char* dst, const u16* src, const int (&off)[4], int tid) {
#pragma unroll
  for (int i = 0; i < NI; ++i) {
    int b = tid * 16 + i * 8192;
    __builtin_amdgcn_global_load_lds((const unsigned*)(src + off[i]), (__attribute__((address_space(3))) unsigned*)(dst + b), 16, 0, 0);
  }
}

template <int MT, int NTW, int NSTG, class Prob, class Epi>
DEV void gemm_phase(char* lds, const Prob& prob, const Epi& epi, int wv) {
  constexpr int NB = NTW / 2;
  constexpr int SSTR = (NTW == 8) ? 65536 : GSTG;
  const int tid = opaque_tid(wv), lane = tid & 63, wr = wv >> 1, wc = wv & 1, fr = lane & 15, fq = lane >> 4;
  int offA[4], offB[4];
#pragma unroll
  for (int i = 0; i < 4; ++i) { int R, C; stage_rc(tid * 16 + i * 8192, R, C); offA[i] = R * prob.lda + C; offB[i] = R * prob.ldb + C; }
  const int lo = (fr * 64 + fq * 16) ^ (((fr >> 3) & 1) << 5);
  const int nk = prob.K / 64;
  const int ntiles = prob.ntiles();
  for (int tile = blockIdx.x; tile < ntiles; tile += gridDim.x) {
    const u16 *Ab, *Bb; int mt, nt;
    prob.get(tile, Ab, Bb, mt, nt);
    f32x4 acc[MT][NTW];
#pragma unroll
    for (int m = 0; m < MT; ++m)
#pragma unroll
      for (int n = 0; n < NTW; ++n) acc[m][n] = f32x4{0.f, 0.f, 0.f, 0.f};
#pragma unroll
    for (int sg = 0; sg < NSTG - 1; ++sg) { stage_tile<MT>(lds + sg * SSTR, Ab + sg * 64, offA, tid); stage_tile<NB>(lds + sg * SSTR + GBO, Bb + sg * 64, offB, tid); }
    epi.pre((float*)(lds + LSCR), mt, nt, tid);
    typename Epi::Regs er; epi.preload(er, mt, nt, wr, wc, fr, fq);
    int sc = 0;
    for (int t = 0; t < nk; ++t) {
      if (NSTG == 3 && t + 1 < nk) { if (MT + NB == 6) asm volatile("s_waitcnt vmcnt(6)" ::: "memory"); else asm volatile("s_waitcnt vmcnt(5)" ::: "memory"); }
      else asm volatile("s_waitcnt vmcnt(0)" ::: "memory");
      __builtin_amdgcn_s_barrier();
      asm volatile("" ::: "memory");
      char* cur = lds + sc * SSTR;
      if (t + NSTG - 1 < nk) { int sn = sc + NSTG - 1; if (sn >= NSTG) sn -= NSTG; char* nxt = lds + sn * SSTR; stage_tile<MT>(nxt, Ab + (t + NSTG - 1) * 64, offA, tid); stage_tile<NB>(nxt + GBO, Bb + (t + NSTG - 1) * 64, offB, tid); }
      sc = (sc == NSTG - 1) ? 0 : sc + 1;
      bf16x8 af[MT][2];
#pragma unroll
      for (int m = 0; m < MT; ++m) af[m][0] = *reinterpret_cast<const bf16x8*>(cur + ((wr * MT + m) * 2 + 0) * 1024 + lo);
#pragma unroll
      for (int nh = 0; nh < NTW / 4; ++nh) {
        bf16x8 bfr[4][2];
#pragma unroll
        for (int n = 0; n < 4; ++n) bfr[n][0] = *reinterpret_cast<const bf16x8*>(cur + GBO + ((wc * NTW + nh * 4 + n) * 2 + 0) * 1024 + lo);
        __builtin_amdgcn_sched_barrier(0);
        if (nh == 0) {
#pragma unroll
          for (int m = 0; m < MT; ++m) af[m][1] = *reinterpret_cast<const bf16x8*>(cur + ((wr * MT + m) * 2 + 1) * 1024 + lo);
        }
#pragma unroll
        for (int n = 0; n < 4; ++n) bfr[n][1] = *reinterpret_cast<const bf16x8*>(cur + GBO + ((wc * NTW + nh * 4 + n) * 2 + 1) * 1024 + lo);
#pragma unroll
        for (int m = 0; m < MT; ++m)
#pragma unroll
          for (int n = 0; n < 4; ++n) acc[m][nh * 4 + n] = __builtin_amdgcn_mfma_f32_16x16x32_bf16(af[m][0], bfr[n][0], acc[m][nh * 4 + n], 0, 0, 0);
        if (nh == 0) {
#pragma unroll
          for (int q = 0; q < MT + 4; ++q) {
            __builtin_amdgcn_sched_group_barrier(0x008, 1, 0);
            __builtin_amdgcn_sched_group_barrier(0x100, 1, 0);
          }
          __builtin_amdgcn_sched_group_barrier(0x008, MT * 4 - (MT + 4), 0);
        } else {
#pragma unroll
          for (int q = 0; q < 4; ++q) {
            __builtin_amdgcn_sched_group_barrier(0x008, 1, 0);
            __builtin_amdgcn_sched_group_barrier(0x100, 1, 0);
          }
          __builtin_amdgcn_sched_group_barrier(0x008, MT * 4 - 4, 0);
        }
        __builtin_amdgcn_sched_barrier(0);
#pragma unroll
        for (int m = 0; m < MT; ++m)
#pragma unroll
          for (int n = 0; n < 4; ++n) acc[m][nh * 4 + n] = __builtin_amdgcn_mfma_f32_16x16x32_bf16(af[m][1], bfr[n][1], acc[m][nh * 4 + n], 0, 0, 0);
        __builtin_amdgcn_sched_barrier(0);
      }
    }
    { int wr2 = wr, wc2 = wc, fr2 = fr, fq2 = fq; asm volatile("" : "+v"(fr2), "+v"(fq2), "+s"(wr2), "+s"(wc2));
      epi.run(acc, er, (const float*)(lds + LSCR), mt, nt, wr2, wc2, fr2, fq2); }
    __syncthreads();
  }
}

struct ProbStd {
  const u16* A; const u16* Bt; int lda, ldb, K, nMt, nNt, bm, bn;
  DEV int ntiles() const { return nMt * nNt; }
  DEV void get(int tile, const u16*& Ab, const u16*& Bb, int& mt, int& nt) const {
    mt = tile % nMt; nt = tile / nMt; Ab = A + (long)mt * bm * lda; Bb = Bt + (long)nt * bn * ldb;
  }
};
struct ProbCache {
  const u16* A; const u16* Bt; int lda, ldb, K;
  DEV int ntiles() const { return 16 * 4; }
  DEV void get(int tile, const u16*& Ab, const u16*& Bb, int& mt, int& nt) const {
    mt = tile & 15; nt = tile >> 4; int l = (mt >> 1) & 3; Ab = A + (long)mt * 256 * lda; Bb = Bt + (long)l * 512 * 128 + (long)nt * 128 * ldb;
  }
};

DEV void pre_rstd(float* s, const float* ss, int mt, int tid) {
  if (tid < 256) {
    const float4* p = reinterpret_cast<const float4*>(ss + (long)(mt * 256 + tid) * 16);
    float4 a = p[0], b = p[1], c = p[2], d = p[3];
    float t = (a.x + a.y + a.z + a.w) + (b.x + b.y + b.z + b.w) + (c.x + c.y + c.z + c.w) + (d.x + d.y + d.z + d.w);
    s[tid] = rsqrtf(t * (1.f / 1024.f) + 1e-6f);
  }
  __syncthreads();
}

struct EpiIn {
  struct Regs {}; DEV void preload(Regs&, int, int, int, int, int, int) const {}
  const float* ss; const float* shW;
  u16* qkv; u16* vt; u16* vgt; const float2* rope; const float* sgu_g;
  float* out; int l;
  DEV void pre(float* s, int mt, int, int tid) const { pre_rstd(s, ss, mt, tid); }
  DEV void run(const f32x4 (&acc)[4][4], const Regs&, const float* s, int mt, int nt, int wr, int wc, int fr, int fq) const {
    const int ridx = ridx_of_mt(mt);
    const float* sh = shW + ridx * INP;
    const int wcb = nt * 128 + wc * 64;
    const bool sample = mt >= 16;
    float shq[4];
#pragma unroll
    for (int n = 0; n < 4; ++n) shq[n] = sh[wcb + n * 16 + fr];
    if (wcb >= C_VS) {
      const int g = (wcb - C_VS) >> 6;
      float ggq[4];
#pragma unroll
      for (int n = 0; n < 4; ++n) ggq[n] = sgu_g[g * 64 + n * 16 + fr];
      __builtin_amdgcn_sched_barrier(0);
#pragma unroll
      for (int m = 0; m < 4; ++m) {
        const int rl = wr * 64 + m * 16 + fq * 4;
        float v[4][4], sq[4] = {0.f, 0.f, 0.f, 0.f};
#pragma unroll
        for (int n = 0; n < 4; ++n) {
          float shv = shq[n];
#pragma unroll
          for (int j = 0; j < 4; ++j) { float x = gelu_t(s[rl + j] * acc[m][n][j] + shv); v[n][j] = x; sq[j] += x * x; }
        }
#pragma unroll
        for (int j = 0; j < 4; ++j) sq[j] = rsqrtf(red16(sq[j]) * (1.f / 64.f) + 1e-6f);
#pragma unroll
        for (int n = 0; n < 4; ++n) {
          int c = n * 16 + fr; float gg = ggq[n];
          st_pk4(vgt + ((long)(((mt * 2 + (rl >> 7)) * 4 + g) * 64 + c)) * 128 + (rl & 127), v[n][0] * sq[0] * gg, v[n][1] * sq[1] * gg, v[n][2] * sq[2] * gg, v[n][3] * sq[3] * gg);
        }
      }
      return;
    }
#pragma unroll
    for (int n = 0; n < 4; ++n) {
      const int cb = wcb + n * 16, col = cb + fr;
      if (cb >= 2080 && cb < C_U) continue;
      const float shv = shq[n];
      const bool isU = cb >= C_U;
      const bool ropeR = (cb >= C_QB && cb < C_VB) || (cb >= C_KPE) || (cb >= C_QC && cb < C_CKV && ((cb - C_QC) % 96) >= 64);
      const bool isVA = (cb >= C_VA && cb < C_QB), isVB = (cb >= C_VB && cb < C_QC);
      float2 csq[4][4];
      if (sample && ropeR) {
        const int i8 = fr & 7; const bool colg = (cb >> 4) & 1;
#pragma unroll
        for (int m = 0; m < 4; ++m)
#pragma unroll
          for (int j = 0; j < 4; ++j) { int t = (mt * 256 + wr * 64 + m * 16 + fq * 4 + j - NP) & 1023; int pos = colg ? (t & 63) : (t >> 6); csq[m][j] = rope[pos * 8 + i8]; }
        __builtin_amdgcn_sched_barrier(0);
      }
#pragma unroll
      for (int m = 0; m < 4; ++m) {
        const int rl = wr * 64 + m * 16 + fq * 4;
        const int row = mt * 256 + rl;
        float v[4];
#pragma unroll
        for (int j = 0; j < 4; ++j) v[j] = s[rl + j] * acc[m][n][j] + shv;
        if (isU) {
#pragma unroll
          for (int j = 0; j < 4; ++j) qkv[(long)(row + j) * INP + col] = f2bf(gelu_t(v[j]));
          continue;
        }
        if (sample && ropeR) {
#pragma unroll
          for (int j = 0; j < 4; ++j) {
            float2 cs = csq[m][j];
            float pr = __shfl_xor(v[j], 8);
            v[j] = (fr < 8) ? (v[j] * cs.x - pr * cs.y) : (v[j] * cs.x + pr * cs.y);
          }
        }
        if (isVA || isVB) {
          int cc = col - (isVA ? C_VA : C_VB); int h = cc >> 6, d = cc & 63;
          u16* base = vt + (isVA ? 0 : (long)NT * 256);
          if (!sample) { int b = row >> 8, sidx = row & 255; st_pk4(base + ((long)((b * 4 + h) * 64 + d)) * 256 + sidx, v[0], v[1], v[2], v[3]); }
          else { int b = (row - NP) >> 10, sidx = (row - NP) & 1023; st_pk4(base + (long)NP * 256 + ((long)((b * 4 + h) * 64 + d)) * 1024 + sidx, v[0], v[1], v[2], v[3]); }
        } else {
#pragma unroll
          for (int j = 0; j < 4; ++j) qkv[(long)(row + j) * INP + col] = f2bf(v[j]);
        }
        if (!sample) {
          const int b = row >> 8, sidx = row & 255;
          long ob = -1; int cc = 0;
          if (cb >= C_KA && cb < C_VA) { ob = O_NAK; cc = col - C_KA; }
          else if (isVA) { ob = O_NAV; cc = col - C_VA; }
          else if (cb >= C_KB && cb < C_VB) { ob = O_DK; cc = col - C_KB; }
          else if (isVB) { ob = O_DV; cc = col - C_VB; }
          if (ob >= 0) {
            int h = cc >> 6, d = cc & 63;
            float* o = out + ob + ((long)(((b * 4 + l) * 4 + h) * 256 + sidx)) * 64 + d;
#pragma unroll
            for (int j = 0; j < 4; ++j) __builtin_nontemporal_store(v[j], o + j * 64);
          } else if (cb >= C_KPE) {
            float* o = out + O_KPE + ((long)((b * 4 + l) * 256 + sidx)) * 32 + (col - C_KPE);
#pragma unroll
            for (int j = 0; j < 4; ++j) __builtin_nontemporal_store(v[j], o + j * 32);
          }
        }
      }
    }
  }
};

struct EpiRes {
  float* x; u16* xa; float* ss; const float* gate;
  const float* gnext; const float* scnext;
  int dry;
  DEV void pre(float*, int, int, int) const {}
  struct Regs { float xr[3][4][4], gt[3][4], an[3][4]; };
  DEV void preload(Regs& r, int mt, int nt, int wr, int wc, int fr, int fq) const {
    const int wcb = nt * 128 + wc * 64;
#pragma unroll
    for (int m = 0; m < 3; ++m) {
      const int row = mt * 192 + wr * 48 + m * 16 + fq * 4;
      const int r16 = mt * 192 + wr * 48 + m * 16;
      const int ridx = (r16 < NP) ? 0 : 1 + ((r16 - NP) >> 10);
#pragma unroll
      for (int n = 0; n < 4; ++n) {
        const int col = wcb + n * 16 + fr;
        r.gt[m][n] = gate[ridx * 6144 + col];
        r.an[m][n] = gnext ? gnext[col] * (1.f + scnext[ridx * 6144 + col]) : 0.f;
#pragma unroll
        for (int j = 0; j < 4; ++j) r.xr[m][n][j] = x[(long)(row + j) * DM + col];
      }
    }
  }
  DEV void run(const f32x4 (&acc)[3][4], const Regs& r, const float*, int mt, int nt, int wr, int wc, int fr, int fq) const {
    const int wcb = nt * 128 + wc * 64;
#pragma unroll
    for (int m = 0; m < 3; ++m) {
      const int row = mt * 192 + wr * 48 + m * 16 + fq * 4;
      float sq[4] = {0.f, 0.f, 0.f, 0.f};
#pragma unroll
      for (int n = 0; n < 4; ++n) {
        const int col = wcb + n * 16 + fr;
#pragma unroll
        for (int j = 0; j < 4; ++j) {
          const long idx = (long)(row + j) * DM + col;
          const float xv = r.xr[m][n][j] + r.gt[m][n] * acc[m][n][j];
          if (!dry) x[idx] = xv; xa[idx] = f2bf(xv * r.an[m][n]); sq[j] += xv * xv;
        }
      }
#pragma unroll
      for (int j = 0; j < 4; ++j) { float t = red16(sq[j]); if (fr == 0) ss[(long)(row + j) * 16 + nt * 2 + wc] = t; }
    }
  }
};

struct EpiFF1 {
  struct Regs {}; DEV void preload(Regs&, int, int, int, int, int, int) const {}
  const float* ss; const float* shW; u16* hid;
  DEV void pre(float* s, int mt, int, int tid) const {
    if (tid < 192) {
      const float4* p = reinterpret_cast<const float4*>(ss + (long)(mt * 192 + tid) * 16);
      float4 a = p[0], b = p[1], c = p[2], d = p[3];
      float t = (a.x + a.y + a.z + a.w) + (b.x + b.y + b.z + b.w) + (c.x + c.y + c.z + c.w) + (d.x + d.y + d.z + d.w);
      s[tid] = rsqrtf(t * (1.f / 1024.f) + 1e-6f);
    }
    __syncthreads();
  }
  DEV void run(const f32x4 (&acc)[3][8], const Regs&, const float* s, int mt, int nt, int wr, int wc, int fr, int fq) const {
    const int wcb = nt * 256 + wc * 128;
    float shq[3][8];
#pragma unroll
    for (int m = 0; m < 3; ++m) {
      const int r16 = mt * 192 + wr * 48 + m * 16;
      const int ridx = (r16 < NP) ? 0 : 1 + ((r16 - NP) >> 10);
#pragma unroll
      for (int n = 0; n < 8; ++n) shq[m][n] = shW[ridx * FF + wcb + n * 16 + fr];
    }
    __builtin_amdgcn_sched_barrier(0);
#pragma unroll
    for (int m = 0; m < 3; ++m) {
      const int rl = wr * 48 + m * 16 + fq * 4; const int row = mt * 192 + rl;
#pragma unroll
      for (int n = 0; n < 8; ++n) {
        int col = wcb + n * 16 + fr; float shv = shq[m][n];
#pragma unroll
        for (int j = 0; j < 4; ++j) { float v = fmaxf(s[rl + j] * acc[m][n][j] + shv, 0.f); hid[(long)(row + j) * FF + col] = f2bf(v * v); }
      }
    }
  }
};

struct EpiUKV {
  struct Regs {}; DEV void preload(Regs&, int, int, int, int, int, int) const {}
  int cache; int l; const u16* qkv; const float* g_ckv; float* out;
  u16* knope; u16* vtc;
  DEV void pre(float* s, int mt, int nt, int tid) const {
    if (cache) { if (tid < 256) s[tid] = 1.f; __syncthreads(); return; }
    int r = tid >> 1, hf = tid & 1; int row = mt * 256 + r;
    const u16* p = qkv + (long)row * INP + C_CKV + hf * 64;
    float v[64]; float sq = 0.f;
#pragma unroll
    for (int i = 0; i < 8; ++i) {
      bf16x8 q = ld16(p + i * 8);
#pragma unroll
      for (int e = 0; e < 8; ++e) { float f = bf2f((u16)q[e]); v[i * 8 + e] = f; sq += f * f; }
    }
    sq += __shfl_xor(sq, 1);
    float rs = rsqrtf(sq * (1.f / 128.f) + 1e-6f);
    if (hf == 0) s[r] = rs;
    if (nt == 0 && mt < 16) {
      int b = row >> 8, sidx = row & 255;
      float* o = out + O_CKV + ((long)((b * 4 + l) * 256 + sidx)) * 128 + hf * 64;
#pragma unroll
      for (int i = 0; i < 16; ++i) {
        float4 w; w.x = v[i * 4] * rs * g_ckv[hf * 64 + i * 4]; w.y = v[i * 4 + 1] * rs * g_ckv[hf * 64 + i * 4 + 1];
        w.z = v[i * 4 + 2] * rs * g_ckv[hf * 64 + i * 4 + 2]; w.w = v[i * 4 + 3] * rs * g_ckv[hf * 64 + i * 4 + 3];
        { typedef float f4v __attribute__((ext_vector_type(4))); f4v ov = {w.x, w.y, w.z, w.w}; __builtin_nontemporal_store(ov, reinterpret_cast<f4v*>(o + i * 4)); }
      }
    }
    __syncthreads();
  }
  DEV void run(const f32x4 (&acc)[4][4], const Regs&, const float* s, int mt, int nt, int wr, int wc, int fr, int fq) const {
    const int wcb = nt * 128 + wc * 64;
#pragma unroll
    for (int n = 0; n < 4; ++n) {
      const int col = wcb + n * 16 + fr;
#pragma unroll
      for (int m = 0; m < 4; ++m) {
        const int rl = wr * 64 + m * 16 + fq * 4; const int row = mt * 256 + rl;
        float v[4];
#pragma unroll
        for (int j = 0; j < 4; ++j) v[j] = s[rl + j] * acc[m][n][j];
        if (wcb < 256) {
#pragma unroll
          for (int j = 0; j < 4; ++j) knope[(long)(row + j) * 256 + col] = f2bf(v[j]);
        } else {
          int h = (col - 256) >> 6, d = col & 63;
          if (cache) { int bl = row >> 9, key = row & 511; st_pk4(vtc + ((long)((bl * 4 + h) * 64 + d)) * 512 + key, v[0], v[1], v[2], v[3]); }
          else if (mt < 16) { int b = row >> 8, sidx = row & 255; st_pk4(vtc + ((long)((b * 4 + h) * 64 + d)) * 256 + sidx, v[0], v[1], v[2], v[3]); }
          else { int b = (row - NP) >> 10, sidx = (row - NP) & 1023; st_pk4(vtc + (long)NP * 256 + ((long)((b * 4 + h) * 64 + d)) * 1024 + sidx, v[0], v[1], v[2], v[3]); }
        }
      }
    }
  }
};

template <int MODE> struct AttnSt { static constexpr int NSM = (MODE == 1) ? 2 : 1; f32x4 O[NSM][4]; float m[NSM], l[NSM]; };
constexpr int AK0 = 0, AK1 = 13312, AV0 = 26624, AV1 = 35840, VSTR = 144;
struct TileSrc { const u16* K; const u16* Pe; const u16* Vt; int ldk, ldpe, ldv; };
DEV const u16* k_src(const TileSrc& s, int c, bool mla) {
  if (mla) { int row = c / 12, cc = c % 12; return (cc < 8) ? (s.K + (long)row * s.ldk + cc * 8) : (s.Pe + (long)row * s.ldpe + (cc - 8) * 8); }
  int row = c >> 3, cc = c & 7; return s.K + (long)row * s.ldk + cc * 8;
}
DEV int k_dst(int c, bool mla) { if (mla) { int row = c / 12, cc = c % 12; return row * 208 + cc * 16; } int row = c >> 3, cc = c & 7; return row * 144 + cc * 16; }
template <int MODE> DEV void stage_load(uint4& k0, uint4& k1, uint4& v0, const TileSrc& s, int tid) {
  k0 = *reinterpret_cast<const uint4*>(k_src(s, tid, MODE == 2));
  if (MODE == 2) { if (tid < 256) k1 = *reinterpret_cast<const uint4*>(k_src(s, tid + 512, true)); }
  { int d = tid >> 3, cc = tid & 7; v0 = *reinterpret_cast<const uint4*>(s.Vt + (long)d * s.ldv + cc * 8); }
}
template <int MODE> DEV void stage_store(const uint4& k0, const uint4& k1, const uint4& v0, char* kbuf, char* vbuf, int tid) {
  *reinterpret_cast<uint4*>(kbuf + k_dst(tid, MODE == 2)) = k0;
  if (MODE == 2) { if (tid < 256) *reinterpret_cast<uint4*>(kbuf + k_dst(tid + 512, true)) = k1; }
  { int d = tid >> 3, cc = tid & 7; *reinterpret_cast<uint4*>(vbuf + d * VSTR + cc * 16) = v0; }
}

template <int MODE>
DEV void attn_compute(AttnSt<MODE>& st, const bf16x8* qf, const char* kbuf, const char* vbuf, float sc, int fr, int fq, bool na, const float* rpbrow, int cq) {
  constexpr int NSM = AttnSt<MODE>::NSM; constexpr int KSTR = (MODE == 2) ? 208 : 144;
  f32x4 s[NSM][4];
  constexpr int KS = (MODE == 2) ? 3 : 2;
  bf16x8 kf[4][KS];
#pragma unroll
  for (int t = 0; t < 4; ++t) {
    const char* kr = kbuf + (16 * t + fr) * KSTR + fq * 16;
#pragma unroll
    for (int ks = 0; ks < KS; ++ks) kf[t][ks] = *reinterpret_cast<const bf16x8*>(kr + 64 * ks);
  }
  __builtin_amdgcn_sched_barrier(0);
#pragma unroll
  for (int t = 0; t < 4; ++t) {
    f32x4 z = {0.f, 0.f, 0.f, 0.f};
    if (MODE == 1) {
      s[0][t] = __builtin_amdgcn_mfma_f32_16x16x32_bf16(kf[t][0], qf[0], z, 0, 0, 0);
      s[NSM - 1][t] = __builtin_amdgcn_mfma_f32_16x16x32_bf16(kf[t][1], qf[1], z, 0, 0, 0);
    } else {
      s[0][t] = __builtin_amdgcn_mfma_f32_16x16x32_bf16(kf[t][0], qf[0], z, 0, 0, 0);
      s[0][t] = __builtin_amdgcn_mfma_f32_16x16x32_bf16(kf[t][1], qf[1], s[0][t], 0, 0, 0);
      if (MODE == 2) s[0][t] = __builtin_amdgcn_mfma_f32_16x16x32_bf16(kf[t][KS - 1], qf[2], s[0][t], 0, 0, 0);
    }
  }
  bf16x8 vfr[2][4];
#pragma unroll
  for (int hh = 0; hh < 2; ++hh)
#pragma unroll
    for (int dt = 0; dt < 4; ++dt) {
      const char* vr = vbuf + (dt * 16 + fr) * VSTR + 8 * fq;
      bf16x4 v0 = *reinterpret_cast<const bf16x4*>(vr + 32 * (2 * hh)), v1 = *reinterpret_cast<const bf16x4*>(vr + 32 * (2 * hh + 1));
      vfr[hh][dt] = bf16x8{v0[0], v0[1], v0[2], v0[3], v1[0], v1[1], v1[2], v1[3]};
    }
  __builtin_amdgcn_sched_barrier(0);
#pragma unroll
  for (int x = 0; x < NSM; ++x) {
    float mx;
    if (MODE == 0 && na) {
      mx = -1e30f;
      int fr2 = fr, fq2 = fq; asm volatile("" : "+v"(fr2), "+v"(fq2));
      const int cqq = cq + fr2; const int c0 = min(max(cqq - 8, 0), 48);
      float bq[4][4];
#pragma unroll
      for (int t = 0; t < 4; ++t)
#pragma unroll
        for (int j = 0; j < 4; ++j) { int ck = 16 * t + 4 * fq2 + j; int bi = min(max(ck - cqq + 15, 0), 30); bq[t][j] = rpbrow[bi]; }
#pragma unroll
      for (int t = 0; t < 4; ++t)
#pragma unroll
        for (int j = 0; j < 4; ++j) {
          int ck = 16 * t + 4 * fq2 + j;
          bool valid = (ck >= c0) && (ck < c0 + 16);
          float v = valid ? __builtin_fmaf(bq[t][j], 1.4426950408889634f, s[x][t][j] * sc) : -1e30f;
          s[x][t][j] = v; mx = fmaxf(mx, v);
        }
    } else {
      float r = -3e38f;
#pragma unroll
      for (int t = 0; t < 4; ++t)
#pragma unroll
        for (int j = 0; j < 4; ++j) r = fmaxf(r, s[x][t][j]);
      mx = r * sc;
    }
    mx = xrow16_max(mx);
    const float mnew = fmaxf(st.m[x], mx); const float alpha = ex2(st.m[x] - mnew); st.m[x] = mnew;
    float ps = 0.f;
    if (MODE == 0 && na) {
#pragma unroll
      for (int t = 0; t < 4; ++t)
#pragma unroll
        for (int j = 0; j < 4; ++j) { float p = ex2(s[x][t][j] - mnew); s[x][t][j] = p; ps += p; }
    } else {
#pragma unroll
      for (int t = 0; t < 4; ++t)
#pragma unroll
        for (int j = 0; j < 4; ++j) { float p = ex2(__builtin_fmaf(s[x][t][j], sc, -mnew)); s[x][t][j] = p; ps += p; }
    }
    st.l[x] = st.l[x] * alpha + ps;
    if (__builtin_amdgcn_ballot_w64(alpha != 1.f) != 0ull) {
#pragma unroll
      for (int dt = 0; dt < 4; ++dt) st.O[x][dt] *= alpha;
    }
  }
#pragma unroll
  for (int hh = 0; hh < 2; ++hh) {
    const int t0 = 2 * hh, t1 = 2 * hh + 1;
    bf16x8 pf[NSM];
#pragma unroll
    for (int x = 0; x < NSM; ++x) {
      uint4 u = {pk2(s[x][t0][0], s[x][t0][1]), pk2(s[x][t0][2], s[x][t0][3]), pk2(s[x][t1][0], s[x][t1][1]), pk2(s[x][t1][2], s[x][t1][3])};
      pf[x] = __builtin_bit_cast(bf16x8, u);
    }
#pragma unroll
    for (int dt = 0; dt < 4; ++dt) {
#pragma unroll
      for (int x = 0; x < NSM; ++x) st.O[x][dt] = __builtin_amdgcn_mfma_f32_16x16x32_bf16(vfr[hh][dt], pf[x], st.O[x][dt], 0, 0, 0);
    }
  }
}

template <int MODE> DEV void attn_init(AttnSt<MODE>& st) {
#pragma unroll
  for (int x = 0; x < AttnSt<MODE>::NSM; ++x) {
    st.m[x] = -1e30f; st.l[x] = 0.f;
#pragma unroll
    for (int dt = 0; dt < 4; ++dt) st.O[x][dt] = f32x4{0.f, 0.f, 0.f, 0.f};
  }
}
DEV float red_fq(float v) { return xrow16_sum(v); }

template <int MODE, class SrcFn>
DEV void attn_run(char* lds, AttnSt<MODE>& st, const bf16x8* qf, int ntiles, const SrcFn& src, float sc, int tid, int na_from, int na_lo, int na_hi, const float* rpbh, int drow0, int cq) {
  const int lane = tid & 63, fr = lane & 15, fq = lane >> 4;
  uint4 ak0, ak1 = {0u, 0u, 0u, 0u}, av0, bk0, bk1 = {0u, 0u, 0u, 0u}, bv0;
  { TileSrc s = src(0); stage_load<MODE>(ak0, ak1, av0, s, tid); stage_store<MODE>(ak0, ak1, av0, lds + AK0, lds + AV0, tid); }
  if (ntiles > 1) { TileSrc s = src(1); stage_load<MODE>(bk0, bk1, bv0, s, tid); }
  __syncthreads();
  for (int i = 0; i < ntiles; i += 2) {
    {
      if (i + 2 < ntiles) { TileSrc s = src(i + 2); stage_load<MODE>(ak0, ak1, av0, s, tid); }
      const bool na = (MODE == 0) && (i >= na_from);
      if (!na || (i >= na_lo && i < na_hi))
        attn_compute<MODE>(st, qf, lds + AK0, lds + AV0, sc, fr, fq, na, rpbh + (long)(drow0 + i) * 31, cq);
      if (i + 1 < ntiles) stage_store<MODE>(bk0, bk1, bv0, lds + AK1, lds + AV1, tid);
      __syncthreads();
    }
    if (i + 1 < ntiles) {
      const int i1 = i + 1;
      if (i1 + 2 < ntiles) { TileSrc s = src(i1 + 2); stage_load<MODE>(bk0, bk1, bv0, s, tid); }
      const bool na = (MODE == 0) && (i1 >= na_from);
      if (!na || (i1 >= na_lo && i1 < na_hi))
        attn_compute<MODE>(st, qf, lds + AK1, lds + AV1, sc, fr, fq, na, rpbh + (long)(drow0 + i1) * 31, cq);
      if (i1 + 1 < ntiles) stage_store<MODE>(ak0, ak1, av0, lds + AK0, lds + AV0, tid);
      __syncthreads();
    }
  }
}

struct MixCtx {
  const Params* p; int l; const u16 *qkv, *knope, *vt, *vgt; u16* obuf;
  const u16 *cKa, *cVtA, *cKb, *cVtB, *cKpe, *cKnope, *cVtC, *sguW;
};

DEV void fin_std(const AttnSt<0>& st, u16* o, int fq) {
  float il = 1.f / red_fq(st.l[0]);
#pragma unroll
  for (int dt = 0; dt < 4; ++dt) st_pk4(o + dt * 16 + 4 * fq, st.O[0][dt][0] * il, st.O[0][dt][1] * il, st.O[0][dt][2] * il, st.O[0][dt][3] * il);
}
DEV void fin_mla(const AttnSt<2>& st, u16* o, int fq) {
  float il = 1.f / red_fq(st.l[0]);
#pragma unroll
  for (int dt = 0; dt < 4; ++dt) st_pk4(o + dt * 16 + 4 * fq, st.O[0][dt][0] * il, st.O[0][dt][1] * il, st.O[0][dt][2] * il, st.O[0][dt][3] * il);
}
DEV void fin_diff(const AttnSt<1>& st, u16* o, int fq, int lane, const Params& p, int l) {
  float lam_init = 0.8f - 0.6f * expf(-0.3f * (float)l);
  float d1 = (lane < 32) ? p.lq1[l * 32 + lane] * p.lk1[l * 32 + lane] : 0.f, d2 = (lane < 32) ? p.lq2[l * 32 + lane] * p.lk2[l * 32 + lane] : 0.f;
  float lam = expf(wave_sum(d1)) - expf(wave_sum(d2)) + lam_init;
  float i1 = 1.f / red_fq(st.l[0]), i2 = lam / red_fq(st.l[1]);
  float o4[4][4], sq = 0.f;
#pragma unroll
  for (int dt = 0; dt < 4; ++dt)
#pragma unroll
    for (int j = 0; j < 4; ++j) { float v = st.O[0][dt][j] * i1 - st.O[1][dt][j] * i2; o4[dt][j] = v; sq += v * v; }
  float rs = rsqrtf(red_fq(sq) * (1.f / 64.f) + 1e-6f) * (1.f - lam_init);
#pragma unroll
  for (int dt = 0; dt < 4; ++dt) {
    const float* g = p.g_subln + l * 64 + dt * 16 + 4 * fq;
    st_pk4(o + dt * 16 + 4 * fq, o4[dt][0] * rs * g[0], o4[dt][1] * rs * g[1], o4[dt][2] * rs * g[2], o4[dt][3] * rs * g[3]);
  }
}

constexpr int MIX_BLOCK_ITEMS = 64 * 3 + 128 * 3 + 192;

DEV void mixer_block_item(char* lds, const MixCtx& M, int it, int tid) {
  const int lane = tid & 63, w = __builtin_amdgcn_readfirstlane(tid >> 6), fr = lane & 15, fq = lane >> 4;
  const Params& p = *M.p; const int l = M.l;
  const float L2E = 1.4426950408889634f;
  const u16* vtA = M.vt; const u16* vtB = M.vt + (long)NT * 256; const u16* vtC = M.vt + (long)2 * NT * 256;
  if (it < 64) {
    int b = it >> 5, h = (it >> 3) & 3, qt = it & 7;
    int row = NP + b * 1024 + qt * 128 + w * 16 + fr;
    bf16x8 qf[2]; qf[0] = ld16(M.qkv + (long)row * INP + C_QB + h * 64 + fq * 8); qf[1] = ld16(M.qkv + (long)row * INP + C_QB + h * 64 + 32 + fq * 8);
    AttnSt<1> st; attn_init<1>(st);
    const int bl = (b * 4 + l) * 4 + h;
    const u16* ck = M.cKb + (long)bl * 512 * 64; const u16* cv = M.cVtB + (long)bl * 64 * 512;
    const u16* nk = M.qkv + (long)(NP + b * 1024) * INP + C_KB + h * 64; const u16* nv = vtB + (long)NP * 256 + (long)((b * 4 + h) * 64) * 1024;
    auto src = [&](int i) { TileSrc s; if (i < 8) { s.K = ck + (long)i * 64 * 64; s.ldk = 64; s.Vt = cv + i * 64; s.ldv = 512; } else { int j = i - 8; s.K = nk + (long)j * 64 * INP; s.ldk = INP; s.Vt = nv + j * 64; s.ldv = 1024; } s.Pe = nullptr; s.ldpe = 0; return s; };
    attn_run<1>(lds, st, qf, 24, src, 0.17677669529663687f * L2E, tid, 1000, 0, 0, p.na_rpb, 0, 0);
    fin_diff(st, M.obuf + (long)row * DM + 256 + h * 64, fq, lane, p, l);
    return;
  }
  it -= 64;
  if (it < 64) {
    int b = it >> 5, h = (it >> 3) & 3, qt = it & 7;
    int row = NP + b * 1024 + qt * 128 + w * 16 + fr;
    bf16x8 qf[3];
#pragma unroll
    for (int ks = 0; ks < 3; ++ks) qf[ks] = ld16(M.qkv + (long)row * INP + C_QC + h * 96 + ks * 32 + fq * 8);
    AttnSt<2> st; attn_init<2>(st);
    const int bl = b * 4 + l;
    const u16* ck = M.cKnope + (long)bl * 512 * 256 + h * 64; const u16* cp = M.cKpe + (long)bl * 512 * 32; const u16* cv = M.cVtC + (long)(bl * 4 + h) * 64 * 512;
    const u16* nk = M.knope + (long)(NP + b * 1024) * 256 + h * 64; const u16* np_ = M.qkv + (long)(NP + b * 1024) * INP + C_KPE; const u16* nv = vtC + (long)NP * 256 + (long)((b * 4 + h) * 64) * 1024;
    auto src = [&](int i) { TileSrc s; if (i < 8) { s.K = ck + (long)i * 64 * 256; s.ldk = 256; s.Pe = cp + (long)i * 64 * 32; s.ldpe = 32; s.Vt = cv + i * 64; s.ldv = 512; } else { int j = i - 8; s.K = nk + (long)j * 64 * 256; s.ldk = 256; s.Pe = np_ + (long)j * 64 * INP; s.ldpe = INP; s.Vt = nv + j * 64; s.ldv = 1024; } return s; };
    attn_run<2>(lds, st, qf, 24, src, 0.10206207261596577f * L2E, tid, 1000, 0, 0, p.na_rpb, 0, 0);
    fin_mla(st, M.obuf + (long)row * DM + 512 + h * 64, fq);
    return;
  }
  it -= 64;
  if (it < 64) {
    int b = it >> 5, h = (it >> 3) & 3, rp = it & 7;
    const int r = rp * 2 + (w >> 2);
    int row = NP + b * 1024 + r * 64 + (w & 3) * 16 + fr;
    bf16x8 qf[2]; qf[0] = ld16(M.qkv + (long)row * INP + C_QA + h * 64 + fq * 8); qf[1] = ld16(M.qkv + (long)row * INP + C_QA + h * 64 + 32 + fq * 8);
    AttnSt<0> st; attn_init<0>(st);
    const int bl = (b * 4 + l) * 4 + h;
    const int r0a = min(max(rp * 2 - 4, 0), 8), r0b = min(max(rp * 2 + 1 - 4, 0), 8), r0w = min(max(r - 4, 0), 8);
    const int nrows = r0b + 8 - r0a;
    const u16* ck = M.cKa + (long)bl * 512 * 64; const u16* cv = M.cVtA + (long)bl * 64 * 512;
    const u16* nk = M.qkv + (long)(NP + b * 1024 + r0a * 64) * INP + C_KA + h * 64; const u16* nv = vtA + (long)NP * 256 + (long)((b * 4 + h) * 64) * 1024 + r0a * 64;
    auto src = [&](int i) { TileSrc s; if (i < 8) { s.K = ck + (long)i * 64 * 64; s.ldk = 64; s.Vt = cv + i * 64; s.ldv = 512; } else { int j = i - 8; s.K = nk + (long)j * 64 * INP; s.ldk = INP; s.Vt = nv + j * 64; s.ldv = 1024; } s.Pe = nullptr; s.ldpe = 0; return s; };
    attn_run<0>(lds, st, qf, 8 + nrows, src, 0.125f * L2E, tid, 8, 8 + (r0w - r0a), 16 + (r0w - r0a), p.na_rpb + (long)((l * 4 + h) * 15) * 31, r0a - 8 - r + 7, (w & 3) * 16);
    fin_std(st, M.obuf + (long)row * DM + 0 + h * 64, fq);
    return;
  }
  it -= 64;
  if (it < 384) {
    int kind = it >> 7; int i2 = it & 127;
    int b = i2 >> 3, h = (i2 >> 1) & 3, qt = i2 & 1;
    int row = b * 256 + qt * 128 + w * 16 + fr;
    if (kind == 0) {
      bf16x8 qf[2]; qf[0] = ld16(M.qkv + (long)row * INP + C_QB + h * 64 + fq * 8); qf[1] = ld16(M.qkv + (long)row * INP + C_QB + h * 64 + 32 + fq * 8);
      AttnSt<1> st; attn_init<1>(st);
      const u16* nk = M.qkv + (long)(b * 256) * INP + C_KB + h * 64; const u16* nv = vtB + (long)((b * 4 + h) * 64) * 256;
      auto src = [&](int i) { TileSrc s; s.K = nk + (long)i * 64 * INP; s.ldk = INP; s.Vt = nv + i * 64; s.ldv = 256; s.Pe = nullptr; s.ldpe = 0; return s; };
      attn_run<1>(lds, st, qf, 4, src, 0.17677669529663687f * L2E, tid, 1000, 0, 0, p.na_rpb, 0, 0);
      fin_diff(st, M.obuf + (long)row * DM + 256 + h * 64, fq, lane, p, l);
    } else if (kind == 1) {
      bf16x8 qf[3];
#pragma unroll
      for (int ks = 0; ks < 3; ++ks) qf[ks] = ld16(M.qkv + (long)row * INP + C_QC + h * 96 + ks * 32 + fq * 8);
      AttnSt<2> st; attn_init<2>(st);
      const u16* nk = M.knope + (long)(b * 256) * 256 + h * 64; const u16* np_ = M.qkv + (long)(b * 256) * INP + C_KPE; const u16* nv = vtC + (long)((b * 4 + h) * 64) * 256;
      auto src = [&](int i) { TileSrc s; s.K = nk + (long)i * 64 * 256; s.ldk = 256; s.Pe = np_ + (long)i * 64 * INP; s.ldpe = INP; s.Vt = nv + i * 64; s.ldv = 256; return s; };
      attn_run<2>(lds, st, qf, 4, src, 0.10206207261596577f * L2E, tid, 1000, 0, 0, p.na_rpb, 0, 0);
      fin_mla(st, M.obuf + (long)row * DM + 512 + h * 64, fq);
    } else {
      bf16x8 qf[2]; qf[0] = ld16(M.qkv + (long)row * INP + C_QA + h * 64 + fq * 8); qf[1] = ld16(M.qkv + (long)row * INP + C_QA + h * 64 + 32 + fq * 8);
      AttnSt<0> st; attn_init<0>(st);
      const u16* nk = M.qkv + (long)(b * 256) * INP + C_KA + h * 64; const u16* nv = vtA + (long)((b * 4 + h) * 64) * 256;
      auto src = [&](int i) { TileSrc s; s.K = nk + (long)i * 64 * INP; s.ldk = INP; s.Vt = nv + i * 64; s.ldv = 256; s.Pe = nullptr; s.ldpe = 0; return s; };
      attn_run<0>(lds, st, qf, 4, src, 0.125f * L2E, tid, 1000, 0, 0, p.na_rpb, 0, 0);
      fin_std(st, M.obuf + (long)row * DM + 0 + h * 64, fq);
    }
    return;
  }
  it -= 384;
  {
    int wi = it * 8 + w;
    int chunk = wi >> 5, g = (wi >> 3) & 3, pt = wi & 7;
    f32x4 D[4];
#pragma unroll
    for (int ct = 0; ct < 4; ++ct) D[ct] = f32x4{0.f, 0.f, 0.f, 0.f};
    const u16* wrow = M.sguW + ((long)((l * 4 + g) * 128 + pt * 16 + fr)) * 128 + fq * 8;
#pragma unroll
    for (int ks = 0; ks < 4; ++ks) {
      bf16x8 bw = ld16(wrow + ks * 32);
#pragma unroll
      for (int ct = 0; ct < 4; ++ct) {
        bf16x8 av = ld16(M.vgt + ((long)((chunk * 4 + g) * 64 + ct * 16 + fr)) * 128 + ks * 32 + fq * 8);
        D[ct] = __builtin_amdgcn_mfma_f32_16x16x32_bf16(av, bw, D[ct], 0, 0, 0);
      }
    }
    int row = chunk * 128 + pt * 16 + fr;
    float bias = p.sgu_b[(l * 4 + g) * 128 + pt * 16 + fr];
#pragma unroll
    for (int ct = 0; ct < 4; ++ct) {
      uint2 uu = *reinterpret_cast<const uint2*>(M.qkv + (long)row * INP + C_U + g * 64 + ct * 16 + 4 * fq);
      st_pk4(M.obuf + (long)row * DM + 768 + g * 64 + ct * 16 + 4 * fq, bflo(uu.x) * (D[ct][0] + bias), bfhi(uu.x) * (D[ct][1] + bias),
             bflo(uu.y) * (D[ct][2] + bias), bfhi(uu.y) * (D[ct][3] + bias));
    }
  }
}

DEV void mixer_phase(char* lds, const MixCtx& M, unsigned* counter, int tid) {
  volatile int* qslot = (volatile int*)(lds + LQSLOT);
  for (;;) {
    if (tid == 0) *qslot = (int)atomicAdd(counter, 1u);
    __syncthreads();
    const int it = __builtin_amdgcn_readfirstlane(*qslot);
    __syncthreads();
    if (it >= MIX_BLOCK_ITEMS) break;
    { int t2 = tid; asm volatile("" : "+v"(t2)); mixer_block_item(lds, M, it, t2); }
  }
}

#define XB_TMO      128
#define XB_XCNT(j)  (256  + 64 * (j))
#define XB_XSUB(j)  (1280 + 64 * (j))
#define XB_XGEN(j)  (2304 + 64 * (j))
#define XB_TOP      3328
#define XB_TOPGEN   3392
#define XCD_BAR_WORDS 3456
#define XB_SPIN_CAP (1u << 18)
#define LAS __attribute__((address_space(3)))

__device__ __forceinline__ unsigned xb_ld(unsigned* p)              { return __hip_atomic_load(p, __ATOMIC_RELAXED, __HIP_MEMORY_SCOPE_AGENT); }
__device__ __forceinline__ unsigned xb_add(unsigned* p, unsigned v) { return __hip_atomic_fetch_add(p, v, __ATOMIC_RELAXED, __HIP_MEMORY_SCOPE_AGENT); }
__device__ __forceinline__ unsigned xb_xcc_id() { return (unsigned)__builtin_amdgcn_s_getreg((3 << 11) | 20) & 0xFu; }
#define XB_SPIN(cond, bar) do { unsigned _sp = 0; while (cond) { __builtin_amdgcn_s_sleep(1); \
    if ((++_sp & 255u) == 0u) { if (xb_ld(&(bar)[XB_TMO])) break; if (_sp > XB_SPIN_CAP) { atomicAdd(&(bar)[XB_TMO], 1u); break; } } } } while (0)

struct XcdBarrier {
    unsigned* bar; unsigned x;
    volatile LAS unsigned* st;
};

__device__ __forceinline__ XcdBarrier xcd_barrier_post(unsigned* bar, volatile LAS unsigned* st) {
    XcdBarrier b; b.bar = bar; b.x = xb_xcc_id(); b.st = st;
    if (threadIdx.x == 0) (void)xb_add(&bar[XB_XCNT(b.x)], 1u);
    return b;
}
__device__ __forceinline__ void xcd_barrier_complete(unsigned* bar, unsigned x, unsigned& nloc, unsigned& nx) {
    const unsigned G = gridDim.x * gridDim.y * gridDim.z;
    unsigned sum, cnt, mine, sp = 0u;
    for (;;) {
        sum = 0u; cnt = 0u; mine = 0u;
#pragma unroll
        for (unsigned j = 0; j < 16; ++j) { const unsigned c = xb_ld(&bar[XB_XCNT(j)]); sum += c; cnt += (c > 0u) ? 1u : 0u; mine = (j == x) ? c : mine; }
        if (sum == G) break;
        __builtin_amdgcn_s_sleep(1);
        if ((++sp & 255u) == 0u) { if (xb_ld(&bar[XB_TMO])) break; if (sp > XB_SPIN_CAP) { atomicAdd(&bar[XB_TMO], 1u); break; } }
    }
    nloc = mine > 0u ? mine : 1u; nx = cnt > 0u ? cnt : 1u;
}

__device__ __forceinline__ void xcd_barrier(const XcdBarrier& b) {
    asm volatile("s_waitcnt vmcnt(0)" ::: "memory");
    __syncthreads();
    if (threadIdx.x == 0) {
        unsigned* bar = b.bar;
        __builtin_amdgcn_s_waitcnt(0);
        unsigned nloc = b.st[0], nx = b.st[1];
        if (nloc == 0u) { xcd_barrier_complete(bar, b.x, nloc, nx); b.st[0] = nloc; b.st[1] = nx; }
        const unsigned old = xb_add(&bar[XB_XSUB(b.x)], 1u);
        const unsigned gen = old / nloc;
        if (old + 1u == (gen + 1u) * nloc) {
            __builtin_amdgcn_fence(__ATOMIC_RELEASE, "agent");
            asm volatile("s_waitcnt vmcnt(0)" ::: "memory");
            const unsigned og = xb_add(&bar[XB_TOP], 1u);
            const unsigned tg = og / nx;
            if (og + 1u == (tg + 1u) * nx) xb_add(&bar[XB_TOPGEN], 1u);
            else XB_SPIN(xb_ld(&bar[XB_TOPGEN]) == tg, bar);
            __builtin_amdgcn_fence(__ATOMIC_ACQUIRE, "agent");
            xb_add(&bar[XB_XGEN(b.x)], 1u);
            asm volatile("s_waitcnt vmcnt(0)" ::: "memory");
        } else {
            XB_SPIN(xb_ld(&bar[XB_XGEN(b.x)]) == gen, bar);
            __builtin_amdgcn_fence(__ATOMIC_ACQUIRE, "agent");
            asm volatile("s_waitcnt vmcnt(0)" ::: "memory");
        }
    }
    __syncthreads();
}


DEV void ada_item(float* sl, const Params& p, float* adap, int idx) {
  int l = idx / 48, rem = idx % 48, ks = rem / 3, cgi = rem % 3;
  int tid = threadIdx.x;
  if (tid < 192) { int r = tid >> 6, k = ks * 64 + (tid & 63); float m = (r == 0) ? p.c_ctx[k] : p.c[(r - 1) * 1024 + k]; sl[tid] = m / (1.f + expf(-m)); }
  __syncthreads();
  int n = cgi * 2048 + tid * 4;
  float4 a0 = {0, 0, 0, 0}, a1 = {0, 0, 0, 0}, a2 = {0, 0, 0, 0};
  const float* w = p.w_ada + ((long)l * 1024 + ks * 64) * 6144 + n;
#pragma unroll 1
  for (int k0 = 0; k0 < 64; k0 += 16) {
    float4 vq[16];
#pragma unroll
    for (int q = 0; q < 16; ++q) vq[q] = NT_LD4(w + (long)(k0 + q) * 6144);
#pragma unroll
    for (int q = 0; q < 16; ++q) {
    const int k = k0 + q; float4 v = vq[q];
    float s0 = sl[k], s1 = sl[64 + k], s2 = sl[128 + k];
    a0.x += s0 * v.x; a0.y += s0 * v.y; a0.z += s0 * v.z; a0.w += s0 * v.w;
    a1.x += s1 * v.x; a1.y += s1 * v.y; a1.z += s1 * v.z; a1.w += s1 * v.w;
    a2.x += s2 * v.x; a2.y += s2 * v.y; a2.z += s2 * v.z; a2.w += s2 * v.w;
    }
  }
  float* o = adap + ((long)(l * 16 + ks) * 3) * 6144 + n;
  *reinterpret_cast<float4*>(o) = a0; *reinterpret_cast<float4*>(o + 6144) = a1; *reinterpret_cast<float4*>(o + 2 * 6144) = a2;
  __syncthreads();
}

struct TrDesc { const float* src; u16* dst; const float* kscale; int ldN, k0, n0, mapmode, ldd, nw; };
DEV void tr_load(float4 (&r)[4], const TrDesc& d, int tid) {
#pragma unroll
  for (int i = 0; i < 4; ++i) {
    int idx = tid + i * 512; int kr = idx >> 5, c4 = (idx & 31) * 4;
    int nd = d.n0 + c4, ns = nd; bool pad = (c4 >= d.nw);
    if (d.mapmode == 1) { if (nd >= C_U) ns = nd - 96; else if (nd >= 2080) pad = true; }
    float4 v = {0.f, 0.f, 0.f, 0.f};
    if (!pad) v = NT_LD4(d.src + (long)(d.k0 + kr) * d.ldN + ns);
    if (d.kscale) { float sc = d.kscale[d.k0 + kr]; v.x *= sc; v.y *= sc; v.z *= sc; v.w *= sc; }
    r[i] = v;
  }
}
DEV void tr_store(float* tl, const float4 (&r)[4], const TrDesc& d, int tid) {
#pragma unroll
  for (int i = 0; i < 4; ++i) {
    int idx = tid + i * 512; int kr = idx >> 5, c4 = (idx & 31) * 4;
    float* t = tl + kr * 129 + c4; t[0] = r[i].x; t[1] = r[i].y; t[2] = r[i].z; t[3] = r[i].w;
  }
  __syncthreads();
  int n = tid >> 2, kc = (tid & 3) * 16;
  if (n < d.nw) {
    unsigned w[8];
#pragma unroll
    for (int i = 0; i < 8; ++i) w[i] = pk2(tl[(kc + 2 * i) * 129 + n], tl[(kc + 2 * i + 1) * 129 + n]);
    uint4* o = reinterpret_cast<uint4*>(d.dst + (long)(d.n0 + n) * d.ldd + d.k0 + kc);
    o[0] = uint4{w[0], w[1], w[2], w[3]}; o[1] = uint4{w[4], w[5], w[6], w[7]};
  }
  __syncthreads();
}

constexpr int T_ADA = 192, T_WIN = 4 * 16 * 21, T_WOUT = 4 * 16 * 8, T_FF1 = 4 * 16 * 32, T_FF2 = 4 * 64 * 8, T_UKV = 64, T_CV = 512;
constexpr int T_TOTAL = T_ADA + T_WIN + T_WOUT + T_FF1 + T_FF2 + T_UKV + T_CV;

DEV void cvt_stream(const float* src, u16* dst, long n, long gtid, long gthreads) {
  for (long i = gtid; i < n / 4; i += gthreads) {
    float4 v = NT_LD4(reinterpret_cast<const float4*>(src) + i);
    uint2 o; o.x = pk2(v.x, v.y); o.y = pk2(v.z, v.w);
    reinterpret_cast<uint2*>(dst)[i] = o;
  }
}

__global__ void __launch_bounds__(512, 2) fwd_megakernel(Params p, int ph_lo, int ph_hi) {
  __shared__ __attribute__((aligned(16))) char lds[LDS_BYTES];
  cg::grid_group grid = cg::this_grid();
  const int wv = __builtin_amdgcn_readfirstlane((int)threadIdx.x >> 6);
  const int tid = opaque_tid(wv), wid = tid >> 6, lane = tid & 63;
  const long gtid = (long)blockIdx.x * NTHR + tid, gthreads = (long)gridDim.x * NTHR;
  const int gwave = blockIdx.x * 8 + wid, gwaves = gridDim.x * 8;
  char* ws = p.ws;
  u16* Wt_in = (u16*)(ws + W_WIN); u16* Wt_out = (u16*)(ws + W_WOUT); u16* Wt_ff1 = (u16*)(ws + W_WFF1); u16* Wt_ff2 = (u16*)(ws + W_WFF2);
  u16* Wt_ukvr = (u16*)(ws + W_UKVR); u16* Wt_ukvg = (u16*)(ws + W_UKVG); u16* sguW = (u16*)(ws + W_SGUW);
  float* xbuf = (float*)(ws + W_X); u16* xa = (u16*)(ws + W_XA); float* ssp = (float*)(ws + W_SS);
  u16* qkv = (u16*)(ws + W_QKV); u16* obuf = (u16*)(ws + W_O); u16* hid = (u16*)(ws + W_HID); u16* knope = (u16*)(ws + W_KNOPE);
  u16* vt = (u16*)(ws + W_VT); u16* vgt = (u16*)(ws + W_VGT);
  u16* cKa = (u16*)(ws + W_CKA); u16* cVtA = (u16*)(ws + W_CVTA); u16* cKb = (u16*)(ws + W_CKB); u16* cVtB = (u16*)(ws + W_CVTB);
  u16* cKpe = (u16*)(ws + W_CKPE); u16* cCkv = (u16*)(ws + W_CCKV); u16* cKnope = (u16*)(ws + W_CKNOPE); u16* cVtC = (u16*)(ws + W_CVTC);
  float* adap = (float*)(ws + W_ADAP); float* E = (float*)(ws + W_E); float* shin = (float*)(ws + W_SHIN); float* shff = (float*)(ws + W_SHFF);
  float2* rope = (float2*)(ws + W_ROPE);

  if (tid < 4) ((volatile unsigned*)(lds + LBARW))[tid] = 0u;
  __syncthreads();
  XcdBarrier xbar = xcd_barrier_post((unsigned*)(ws + W_BAR), (volatile LAS unsigned*)(lds + LBARW));
  if (ph_hi < 0) grid.sync();
  int ph = 0;
#ifndef REPMASK
#define REPMASK 0
#endif
#define NREP(id) ((((REPMASK) >> (id)) & 1) ? 2 : 1)
#define PHASE_BEGIN(id) if (ph >= ph_lo && ph < ph_hi) { for (int rep = 0; rep < NREP(id); ++rep) { if (rep) xcd_barrier(xbar); const int dry = (rep + 1 < NREP(id)) ? 1 : 0; (void)dry;
#define PHASE_END } } ++ph; if (ph > ph_lo && ph < ph_hi) xcd_barrier(xbar);

  PHASE_BEGIN(0)
  for (int it = blockIdx.x; it < T_ADA; it += gridDim.x) ada_item((float*)lds, p, adap, it);
  {
    auto decode = [&](int i, TrDesc& d) {
      d.kscale = nullptr; d.mapmode = 0; d.nw = 128;
      if (i < T_WIN) { int l = i / 336, rem = i % 336, kt = rem / 21, ntl = rem % 21; d.src = p.w_in + (long)l * DM * INC; d.ldN = INC; d.k0 = kt * 64; d.n0 = ntl * 128; d.mapmode = 1; d.dst = Wt_in + (long)l * INP * DM; d.ldd = DM; return; }
      i -= T_WIN;
      if (i < T_WOUT) { int l = i >> 7, rem = i & 127, kt = rem >> 3, ntl = rem & 7; d.src = p.w_out + (long)l * DM * DM; d.ldN = DM; d.k0 = kt * 64; d.n0 = ntl * 128; d.dst = Wt_out + (long)l * DM * DM; d.ldd = DM; return; }
      i -= T_WOUT;
      if (i < T_FF1) { int l = i >> 9, rem = i & 511, kt = rem >> 5, ntl = rem & 31; d.src = p.w_ff1 + (long)l * DM * FF; d.ldN = FF; d.k0 = kt * 64; d.n0 = ntl * 128; d.dst = Wt_ff1 + (long)l * FF * DM; d.ldd = DM; return; }
      i -= T_FF1;
      if (i < T_FF2) { int l = i >> 9, rem = i & 511, kt = rem >> 3, ntl = rem & 7; d.src = p.w_ff2 + (long)l * FF * DM; d.ldN = DM; d.k0 = kt * 64; d.n0 = ntl * 128; d.dst = Wt_ff2 + (long)l * DM * FF; d.ldd = FF; return; }
      i -= T_FF2;
      if (i < T_UKV) {
        int l = i >> 4, which = (i >> 3) & 1, fold = (i >> 2) & 1, kt = (i >> 1) & 1, ntl = i & 1;
        d.src = (which ? p.w_uv : p.w_uk) + (long)l * 128 * 256; d.ldN = 256; d.k0 = kt * 64; d.n0 = ntl * 128;
        d.dst = (fold ? Wt_ukvg : Wt_ukvr) + (long)l * 512 * 128 + (long)which * 256 * 128; d.ldd = 128; d.kscale = fold ? (p.g_ckv + l * 128) : nullptr; return;
      }
      i -= T_UKV;
      { int which = i >> 8, mat = (i >> 3) & 31, kt = i & 7;
        d.src = (which ? p.c_diff_v : p.c_na_v) + (long)mat * 512 * 64; d.ldN = 64; d.k0 = kt * 64; d.n0 = 0; d.nw = 64;
        d.dst = (which ? cVtB : cVtA) + (long)mat * 64 * 512; d.ldd = 512; }
    };
    constexpr int NTR = T_TOTAL - T_ADA;
    int i = blockIdx.x;
    if (i < NTR) {
      TrDesc cur, nxt; float4 rc[4], rn[4];
      decode(i, cur); tr_load(rc, cur, tid);
      for (; i < NTR; i += gridDim.x) {
        const int inext = i + gridDim.x; const bool more = inext < NTR;
        if (more) { decode(inext, nxt); tr_load(rn, nxt, tid); }
        tr_store((float*)lds, rc, cur, tid);
        if (more) { cur = nxt;
#pragma unroll
          for (int q = 0; q < 4; ++q) rc[q] = rn[q]; }
      }
    }
  }
  cvt_stream(p.c_na_k, cKa, 1048576, gtid, gthreads);
  cvt_stream(p.c_diff_k, cKb, 1048576, gtid, gthreads);
  cvt_stream(p.c_mla_kpe, cKpe, 131072, gtid, gthreads);
  cvt_stream(p.c_mla_ckv, cCkv, 524288, gtid, gthreads);
  cvt_stream(p.sgu_w, sguW, 262144, gtid, gthreads);
  if (gtid < 512) {
    int pos = (int)gtid >> 3, i = (int)gtid & 7;
    float freq = powf(10000.f, -(float)i / 8.f); float ang = (float)pos * freq;
    rope[gtid] = make_float2(cosf(ang), sinf(ang));
  }
  PHASE_END

  PHASE_BEGIN(1)
  for (long i = gtid; i < (long)NL * 3 * 6144; i += gthreads) {
    int l = (int)(i / 18432), rem = (int)(i % 18432), r = rem / 6144, n = rem % 6144;
    float a = p.b_ada[l * 6144 + n];
#pragma unroll
    for (int ks = 0; ks < 16; ++ks) a += adap[((long)(l * 16 + ks) * 3 + r) * 6144 + n];
    E[i] = a;
  }
  PHASE_END

  PHASE_BEGIN(2)
  {
    ProbCache pc{cCkv, Wt_ukvr, 128, 128, 128};
    EpiUKV ec{1, 0, nullptr, nullptr, nullptr, cKnope, cVtC};
    gemm_phase<4, 4, 3>(lds, pc, ec, wv);
  }
  for (int it4 = gwave * 4; it4 < NL * (INP + FF); it4 += gwaves * 4) {
    int l, n; const u16* wrow; const float* sh; float* dst; int ldd;
    if (it4 < NL * INP) { l = it4 / INP; n = it4 % INP; wrow = Wt_in + ((long)l * INP + n) * DM; sh = E + (long)l * 18432 + 0; dst = shin + (long)l * 3 * INP + n; ldd = INP; }
    else { int j = it4 - NL * INP; l = j / FF; n = j % FF; wrow = Wt_ff1 + ((long)l * FF + n) * DM; sh = E + (long)l * 18432 + 3072; dst = shff + (long)l * 3 * FF + n; ldd = FF; }
    bf16x8 wq[4][2];
#pragma unroll
    for (int c = 0; c < 4; ++c)
#pragma unroll
      for (int hlf = 0; hlf < 2; ++hlf) wq[c][hlf] = ld16(wrow + (long)c * DM + hlf * 512 + lane * 8);
    float acc3[4][3];
#pragma unroll
    for (int c = 0; c < 4; ++c) { acc3[c][0] = 0.f; acc3[c][1] = 0.f; acc3[c][2] = 0.f; }
#pragma unroll
    for (int hlf = 0; hlf < 2; ++hlf) {
      const int k = hlf * 512 + lane * 8;
      float s0[8], s1[8], s2[8];
#pragma unroll
      for (int e = 0; e < 8; ++e) { s0[e] = sh[k + e]; s1[e] = sh[6144 + k + e]; s2[e] = sh[2 * 6144 + k + e]; }
#pragma unroll
      for (int c = 0; c < 4; ++c)
#pragma unroll
        for (int e = 0; e < 8; ++e) { float wf = bf2f((u16)wq[c][hlf][e]); acc3[c][0] += wf * s0[e]; acc3[c][1] += wf * s1[e]; acc3[c][2] += wf * s2[e]; }
    }
#pragma unroll
    for (int c = 0; c < 4; ++c) {
      float a0 = wave_sum(acc3[c][0]), a1 = wave_sum(acc3[c][1]), a2 = wave_sum(acc3[c][2]);
      if (lane == 0) { dst[c] = a0; dst[ldd + c] = a1; dst[2 * ldd + c] = a2; }
    }
  }
  for (int row = gwave; row < NT; row += gwaves) {
    const float* src = (row < NP) ? (p.x_prompt + (long)row * DM) : (p.x_sample + (long)(row - NP) * DM);
    int ridx = (row < NP) ? 0 : 1 + ((row - NP) >> 10);
    const float* sc1 = E + ridx * 6144 + 1024;
    float sq = 0.f;
    float4 vq[4], gq[4], sq4[4];
#pragma unroll
    for (int i = 0; i < 4; ++i) { int k = i * 256 + lane * 4; vq[i] = NT_LD4(src + k); gq[i] = *reinterpret_cast<const float4*>(p.g_mix + k); sq4[i] = *reinterpret_cast<const float4*>(sc1 + k); }
#pragma unroll
    for (int i = 0; i < 4; ++i) {
      int k = i * 256 + lane * 4;
      float4 v = vq[i], g = gq[i], s = sq4[i];
      *reinterpret_cast<float4*>(xbuf + (long)row * DM + k) = v;
      sq += v.x * v.x + v.y * v.y + v.z * v.z + v.w * v.w;
      st_pk4(xa + (long)row * DM + k, v.x * g.x * (1.f + s.x), v.y * g.y * (1.f + s.y), v.z * g.z * (1.f + s.z), v.w * g.w * (1.f + s.w));
    }
    sq = wave_sum(sq);
    if (lane < 16) ssp[(long)row * 16 + lane] = (lane == 0) ? sq : 0.f;
  }
  PHASE_END

#pragma unroll 1
  for (int l = 0; l < NL; ++l) {
    const float* El = E + (long)l * 18432;
    PHASE_BEGIN(3)
    { ProbStd pb{xa, Wt_in + (long)l * INP * DM, DM, DM, DM, 24, 21, 256, 128};
      EpiIn ep{ssp, shin + (long)l * 3 * INP, qkv, vt, vgt, rope, p.sgu_g + l * 256, p.out, l};
      gemm_phase<4, 4, 3>(lds, pb, ep, wv); }
    PHASE_END
    PHASE_BEGIN(4)
    { ProbStd pb{qkv + C_CKV, Wt_ukvg + (long)l * 512 * 128, INP, 128, 128, 24, 4, 256, 128};
      EpiUKV ep{0, l, qkv, p.g_ckv + l * 128, p.out, knope, vt + (long)2 * NT * 256};
      gemm_phase<4, 4, 3>(lds, pb, ep, wv); }
    PHASE_END
    PHASE_BEGIN(5)
    { MixCtx M{&p, l, qkv, knope, vt, vgt, obuf, cKa, cVtA, cKb, cVtB, cKpe, cKnope, cVtC, sguW};
      mixer_phase(lds, M, (unsigned*)(ws + W_CNT) + l * 64 + rep * 16, opaque_tid(wv)); }
    PHASE_END
    PHASE_BEGIN(6)
    { ProbStd pb{obuf, Wt_out + (long)l * DM * DM, DM, DM, DM, 32, 8, 192, 128};
      EpiRes ep{xbuf, xa, ssp, El + 2048, p.g_ffn + l * DM, El + 4096, dry};
      gemm_phase<3, 4, 3>(lds, pb, ep, wv); }
    PHASE_END
    PHASE_BEGIN(7)
    { ProbStd pb{xa, Wt_ff1 + (long)l * FF * DM, DM, DM, DM, 32, 16, 192, 256};
      EpiFF1 ep{ssp, shff + (long)l * 3 * FF, hid};
      gemm_phase<3, 8, 2>(lds, pb, ep, wv); }
    PHASE_END
    PHASE_BEGIN(8)
    { ProbStd pb{hid, Wt_ff2 + (long)l * DM * FF, FF, FF, FF, 32, 8, 192, 128};
      EpiRes ep{xbuf, xa, ssp, El + 5120, (l + 1 < NL) ? (p.g_mix + (l + 1) * DM) : nullptr, (l + 1 < NL) ? (E + (long)(l + 1) * 18432 + 1024) : nullptr, dry};
      gemm_phase<3, 4, 3>(lds, pb, ep, wv); }
    PHASE_END
  }

  PHASE_BEGIN(9)
  const int t9 = opaque_tid(wv); const int lane9 = t9 & 63;
  for (int row = blockIdx.x * 8 + (t9 >> 6); row < NT; row += gridDim.x * 8) {
    const int lane = lane9;
    float t = (lane < 16) ? ssp[(long)row * 16 + lane] : 0.f;
    t = wave_sum(t);
    float rs = rsqrtf(t * (1.f / 1024.f) + 1e-6f);
    float4 vq[4], gq[4];
#pragma unroll
    for (int i = 0; i < 4; ++i) { int k = i * 256 + lane * 4; vq[i] = NT_LD4(xbuf + (long)row * DM + k); gq[i] = *reinterpret_cast<const float4*>(p.g_final + k); }
#pragma unroll
    for (int i = 0; i < 4; ++i) {
      int k = i * 256 + lane * 4;
      float4 v = vq[i], g = gq[i];
      float4 o = {v.x * rs * g.x, v.y * rs * g.y, v.z * rs * g.z, v.w * rs * g.w};
      { typedef float f4v __attribute__((ext_vector_type(4))); f4v ov = {o.x, o.y, o.z, o.w}; __builtin_nontemporal_store(ov, reinterpret_cast<f4v*>(p.out + (long)row * DM + k)); }
    }
  }
  PHASE_END
}

extern "C" void kernel_launch(void* const* d_in, const int* in_sizes, int n_in, void* d_out, int out_size, void* d_ws, size_t ws_size, hipStream_t stream) {
  static int grid_blocks = 0;
  if (!grid_blocks) {
    int dev = 0, cus = 0, per_cu = 0;
    hipGetDevice(&dev);
    hipDeviceGetAttribute(&cus, hipDeviceAttributeMultiprocessorCount, dev);
    hipOccupancyMaxActiveBlocksPerMultiprocessor(&per_cu, fwd_megakernel, NTHR, 0);
    if (per_cu > 1) per_cu = 1;
    grid_blocks = cus * per_cu;
  }
  if (ws_size < W_END) { fprintf(stderr, "workspace too small: %zu < %zu\n", ws_size, (size_t)W_END); return; }
  Params p{};
  const float** f = (const float**)&p;
  for (int i = 0; i < 31; ++i) f[i] = (const float*)d_in[i];
  p.out = (float*)d_out; p.ws = (char*)d_ws;
  if (hipMemsetAsync((char*)d_ws + W_BAR, 0, W_END - W_BAR, stream) != hipSuccess) { fprintf(stderr, "memset failed\n"); return; }
  int lo = 0, hi = 1000;
  void* args[] = {&p, &lo, &hi};
  hipError_t e = hipLaunchCooperativeKernel((void*)fwd_megakernel, dim3(grid_blocks), dim3(NTHR), args, 0, stream);
  if (e != hipSuccess) fprintf(stderr, "cooperative launch failed: %s (grid %d)\n", hipGetErrorString(e), grid_blocks);
}
```
